# Optimizing an MI355X kernel written in HIP

```python
import functools
import jax, jax.numpy as jnp
from jax import lax
import numpy as np

D_MODEL = 1024
BATCH = 2
SEQ = 16384
DEPTH = 1
DEC_BATCH = 32
DEC_SEQ = 16
PAST_LEN = 2048

CHUNK = 64
WINDOW = 128
N_WIN_CHUNKS = WINDOW // CHUNK
ATTN_WIDTH = D_MODEL // 2
N_HEADS = 8
HEAD_DIM = ATTN_WIDTH // N_HEADS
N_KV_HEADS = 2
GQA_GROUP = N_HEADS // N_KV_HEADS
Q_DIM = N_HEADS * HEAD_DIM
KV_DIM = N_KV_HEADS * HEAD_DIM
POOL_WIDTH = D_MODEL - ATTN_WIDTH
POOL_WINDOWS = (2, 4, 8, 16)
N_POOL_GROUPS = len(POOL_WINDOWS)
POOL_GROUP_DIM = POOL_WIDTH // N_POOL_GROUPS
POOL_HIST = max(POOL_WINDOWS) - 1
IN_PROJ_DIM = Q_DIM + 2 * KV_DIM + POOL_WIDTH
D_FF = 4 * D_MODEL
PLE_DIM = 256
RMS_EPS = 1e-6

kernel_name = "hymba_swa_sink_pool_stream_step"


def rmsnorm(x, g):
    xf = x.astype(jnp.float32)
    y = xf * lax.rsqrt(jnp.mean(xf * xf, axis=-1, keepdims=True) + RMS_EPS)
    return (y * g.astype(jnp.float32)).astype(x.dtype)


def sink_softmax(s, valid, sink_b):
    s = jnp.where(valid, s, -jnp.inf)
    m = jnp.maximum(jnp.max(s, axis=-1, keepdims=True), sink_b)
    e = jnp.exp(s - m)
    denom = jnp.sum(e, axis=-1, keepdims=True) + jnp.exp(sink_b - m)
    return e / denom


def attn_prompt(q, k, v, sinks):
    B, S = q.shape[:2]
    nc = S // CHUNK
    kl = WINDOW + CHUNK
    pad = ((0, 0), (WINDOW, 0), (0, 0), (0, 0))
    kp = jnp.pad(k, pad).reshape(B, nc + N_WIN_CHUNKS, CHUNK, N_KV_HEADS, HEAD_DIM)
    vp = jnp.pad(v, pad).reshape(B, nc + N_WIN_CHUNKS, CHUNK, N_KV_HEADS, HEAD_DIM)
    kb = jnp.concatenate([kp[:, j:j + nc] for j in range(N_WIN_CHUNKS + 1)], axis=2)
    vb = jnp.concatenate([vp[:, j:j + nc] for j in range(N_WIN_CHUNKS + 1)], axis=2)
    qb = q.reshape(B, nc, CHUNK, N_KV_HEADS, GQA_GROUP, HEAD_DIM)
    s = jnp.einsum('bcqkgd,bcskd->bckgqs', qb, kb,
                   preferred_element_type=jnp.float32) * (HEAD_DIM ** -0.5)
    key_pos = (jnp.arange(nc)[:, None] - N_WIN_CHUNKS) * CHUNK + jnp.arange(kl)[None, :]
    valid = (key_pos >= 0)[None, :, None, None, None, :]
    sink_b = sinks.astype(jnp.float32).reshape(1, 1, N_KV_HEADS, GQA_GROUP, 1, 1)
    p = sink_softmax(s, valid, sink_b)
    o = jnp.einsum('bckgqs,bcskd->bcqkgd', p.astype(v.dtype), vb)
    return o.reshape(B, S, ATTN_WIDTH)


def attn_sample(q, k, v, cache_k, cache_v, sinks):
    B, T = q.shape[:2]
    kf = jnp.concatenate([cache_k.astype(k.dtype), k], axis=1)
    vf = jnp.concatenate([cache_v.astype(v.dtype), v], axis=1)
    qs = q.reshape(B, T, N_KV_HEADS, GQA_GROUP, HEAD_DIM)
    s = jnp.einsum('btkgd,bskd->bkgts', qs, kf,
                   preferred_element_type=jnp.float32) * (HEAD_DIM ** -0.5)
    sink_b = sinks.astype(jnp.float32).reshape(1, N_KV_HEADS, GQA_GROUP, 1, 1)
    p = sink_softmax(s, True, sink_b)
    o = jnp.einsum('bkgts,bskd->btkgd', p.astype(v.dtype), vf)
    return o.reshape(B, T, ATTN_WIDTH)


def multiscale_pool(u, hist, pos0, w_pool, pool_scale):
    T = u.shape[1]
    ext = jnp.concatenate([hist.astype(u.dtype), u], axis=1)
    extf = ext.astype(jnp.float32)
    cs = jnp.cumsum(jnp.pad(extf, ((0, 0), (1, 0), (0, 0))), axis=1)
    pos = pos0 + jnp.arange(T)
    outs = []
    for g, w in enumerate(POOL_WINDOWS):
        lo_c, hi_c = g * POOL_GROUP_DIM, (g + 1) * POOL_GROUP_DIM
        hi = cs[:, POOL_HIST + 1:POOL_HIST + 1 + T, lo_c:hi_c]
        lo = cs[:, POOL_HIST + 1 - w:POOL_HIST + 1 - w + T, lo_c:hi_c]
        cnt = jnp.minimum(pos + 1, w).astype(jnp.float32)[None, :, None]
        d = (hi - lo) / cnt - extf[:, POOL_HIST:, lo_c:hi_c]
        outs.append(jnp.einsum('btc,ce->bte', d, w_pool[g].astype(jnp.float32)))
    b = jnp.concatenate(outs, axis=-1) * pool_scale.astype(jnp.float32)
    return b.astype(u.dtype), ext[:, -POOL_HIST:]


def trunk_layer(x, ple, attn_fn, pool_hist, pos0, ln_mix, w_in, g_attn_out, w_pool,
                pool_scale, g_pool_out, w_out, ln_ffn, w_up, w_down, ln_ple,
                w_ple_gate, w_ple_proj):
    B, T, _ = x.shape
    h = rmsnorm(x, ln_mix)
    z = jnp.einsum('btd,de->bte', h, w_in)
    q = z[..., :Q_DIM].reshape(B, T, N_HEADS, HEAD_DIM)
    k = z[..., Q_DIM:Q_DIM + KV_DIM].reshape(B, T, N_KV_HEADS, HEAD_DIM)
    v = z[..., Q_DIM + KV_DIM:Q_DIM + 2 * KV_DIM].reshape(B, T, N_KV_HEADS, HEAD_DIM)
    u = z[..., Q_DIM + 2 * KV_DIM:]
    a = attn_fn(q, k, v)
    b, new_pool = multiscale_pool(u, pool_hist, pos0, w_pool, pool_scale)
    mix = jnp.concatenate([rmsnorm(a, g_attn_out), rmsnorm(b, g_pool_out)], axis=-1)
    x = x + jnp.einsum('bte,ed->btd', mix, w_out)
    hf = rmsnorm(x, ln_ffn)
    x = x + jnp.einsum('btf,fd->btd', jnp.square(jax.nn.relu(jnp.einsum('btd,df->btf', hf, w_up))), w_down)
    gate = jax.nn.sigmoid(jnp.einsum('btd,de->bte', rmsnorm(x, ln_ple), w_ple_gate))
    x = x + gate * jnp.einsum('btp,pd->btd', ple, w_ple_proj)
    return x, k, v, new_pool


def setup_inputs(seed: int = 0) -> dict:
    key = jax.random.key(seed)
    ks = jax.random.split(key, 24)
    f32 = jnp.float32

    def nrm(k, shape, scale=1.0):
        return jax.random.normal(k, shape, f32) * scale

    def gain(k, shape):
        return 1.0 + 0.05 * jax.random.normal(k, shape, f32)

    return {
        "x_prompt": nrm(ks[0], (BATCH, SEQ, D_MODEL)),
        "x_sample": nrm(ks[1], (DEC_BATCH, DEC_SEQ, D_MODEL)),
        "cache_k": nrm(ks[2], (DEPTH, DEC_BATCH, WINDOW, N_KV_HEADS, HEAD_DIM)),
        "cache_v": nrm(ks[3], (DEPTH, DEC_BATCH, WINDOW, N_KV_HEADS, HEAD_DIM)),
        "state_pool": nrm(ks[4], (DEPTH, DEC_BATCH, POOL_HIST, POOL_WIDTH)),
        "p_prompt": nrm(ks[5], (DEPTH, BATCH, SEQ, PLE_DIM)),
        "p_sample": nrm(ks[6], (DEPTH, DEC_BATCH, DEC_SEQ, PLE_DIM)),
        "ln_mix": gain(ks[7], (DEPTH, D_MODEL)),
        "w_in": nrm(ks[8], (DEPTH, D_MODEL, IN_PROJ_DIM), D_MODEL ** -0.5),
        "attn_sinks": nrm(ks[9], (DEPTH, N_HEADS), 0.5),
        "g_attn_out": gain(ks[10], (DEPTH, ATTN_WIDTH)),
        "w_pool": nrm(ks[11], (DEPTH, N_POOL_GROUPS, POOL_GROUP_DIM, POOL_GROUP_DIM), POOL_GROUP_DIM ** -0.5),
        "pool_scale": 0.5 + 0.05 * jax.random.normal(ks[12], (DEPTH, POOL_WIDTH), f32),
        "g_pool_out": gain(ks[13], (DEPTH, POOL_WIDTH)),
        "w_out": nrm(ks[14], (DEPTH, D_MODEL, D_MODEL), D_MODEL ** -0.5),
        "ln_ffn": gain(ks[15], (DEPTH, D_MODEL)),
        "w_up": nrm(ks[16], (DEPTH, D_MODEL, D_FF), D_MODEL ** -0.5),
        "w_down": nrm(ks[17], (DEPTH, D_FF, D_MODEL), D_FF ** -0.5),
        "ln_ple": gain(ks[18], (DEPTH, D_MODEL)),
        "w_ple_gate": nrm(ks[19], (DEPTH, D_MODEL, D_MODEL), D_MODEL ** -0.5),
        "w_ple_proj": nrm(ks[20], (DEPTH, PLE_DIM, D_MODEL), PLE_DIM ** -0.5),
        "ln_final": gain(ks[21], (D_MODEL,)),
    }


def reference(x_prompt, x_sample, cache_k, cache_v, state_pool, p_prompt, p_sample,
              ln_mix, w_in, attn_sinks, g_attn_out, w_pool, pool_scale, g_pool_out,
              w_out, ln_ffn, w_up, w_down, ln_ple, w_ple_gate, w_ple_proj, ln_final):
    xp, xs = x_prompt, x_sample
    kp_l, vp_l, pp_l, ks_l, vs_l, ps_l = [], [], [], [], [], []
    for i in range(DEPTH):
        shared = (ln_mix[i], w_in[i], g_attn_out[i], w_pool[i], pool_scale[i], g_pool_out[i],
                  w_out[i], ln_ffn[i], w_up[i], w_down[i], ln_ple[i], w_ple_gate[i], w_ple_proj[i])
        fn_p = functools.partial(attn_prompt, sinks=attn_sinks[i])
        hist_p = jnp.zeros((xp.shape[0], POOL_HIST, POOL_WIDTH), xp.dtype)
        xp, k_p, v_p, pool_p = trunk_layer(xp, p_prompt[i], fn_p, hist_p, 0, *shared)
        fn_s = functools.partial(attn_sample, cache_k=cache_k[i], cache_v=cache_v[i], sinks=attn_sinks[i])
        xs, k_s, v_s, pool_s = trunk_layer(xs, p_sample[i], fn_s, state_pool[i], PAST_LEN, *shared)
        kp_l.append(k_p[:, -WINDOW:])
        vp_l.append(v_p[:, -WINDOW:])
        pp_l.append(pool_p)
        ks_l.append(k_s)
        vs_l.append(v_s)
        ps_l.append(pool_s)
    y_prompt = rmsnorm(xp, ln_final)
    y_sample = rmsnorm(xs, ln_final)
    new_k_prompt = jnp.stack(kp_l)
    new_v_prompt = jnp.stack(vp_l)
    new_pool_prompt = jnp.stack(pp_l)
    new_k_sample = jnp.stack(ks_l)
    new_v_sample = jnp.stack(vs_l)
    new_pool_sample = jnp.stack(ps_l)
    return (y_prompt, y_sample, new_k_prompt, new_v_prompt, new_pool_prompt,
            new_k_sample, new_v_sample, new_pool_sample)
```

```cpp
#include <hip/hip_runtime.h>
#include <hip/hip_cooperative_groups.h>
#include <hip/hip_bf16.h>
#include <cstdio>
#include <cstdint>
namespace cg = cooperative_groups;
namespace pg8 {
#define PG8_LAS __attribute__((address_space(3)))
typedef unsigned short bf16_t;
typedef short bf16x8 __attribute__((ext_vector_type(8)));
typedef float f32x4 __attribute__((ext_vector_type(4)));
typedef unsigned u32x4 __attribute__((ext_vector_type(4)));
constexpr int BM = 256, BK = 64, HALF = 128, HTB = HALF * BK * 2  , STAGE_BYTES = 8 * HTB, NXCD = 8, WGM = 8;

__host__ __device__ __forceinline__ int lds_byte(int r, int c) { const int st = (r >> 4) * 2 + (c >> 5), rr = r & 15, cc = c & 31, ob = rr * 64 + cc * 2; return st * 1024 + (ob ^ (((ob >> 9) & 1) << 5)); }
__host__ __device__ __forceinline__ void stage_rc(int b, int& R, int& C) { const int st = b / 1024, sb = b % 1024, swz = sb ^ (((sb >> 9) & 1) << 5); R = (st >> 1) * 16 + swz / 64; C = (st & 1) * 32 + (swz % 64) / 2; }
__host__ __device__ __forceinline__ int perm32(int rho) { const int n = rho >> 4, i = rho & 15; return 8 * (i >> 2) + 4 * n + (i & 3); }

struct Unit { int pm, pn; };
struct Gemm { const bf16_t* A; const bf16_t* Bt; int M, N, K; };

struct StaticOrder {
    int nM, nN, nwg, G, c;
    __host__ __device__ void init(int M, int N, int G_, int c_) { nM = M / BM; nN = N / BM; nwg = nM * nN; G = G_; c = c_; }
    __host__ __device__ bool next(int i, Unit& u) const {
        const long L = (long)i * G + c; if (L >= nwg) return false;
        int wgid = (int)L; { const int q = nwg / NXCD, r = nwg % NXCD, xcd = wgid % NXCD, off = wgid / NXCD; wgid = (xcd < r ? xcd * (q + 1) : r * (q + 1) + (xcd - r) * q) + off; }
        const int nig = WGM * nN, gid = wgid / nig, fm = gid * WGM, gsz = (nM - fm) < WGM ? (nM - fm) : WGM;
        u.pm = fm + ((wgid % nig) % gsz); u.pn = (wgid % nig) / gsz; return true;
    }
    __device__ __forceinline__ void a_ready(const Unit&) const {}
    __device__ __forceinline__ void done(const Unit&) const {}
};

__device__ __forceinline__ unsigned cvt_pk_bf16(float lo, float hi) { unsigned r; asm volatile("v_cvt_pk_bf16_f32 %0, %1, %2" : "=v"(r) : "v"(lo), "v"(hi)); return r; }
typedef float f32x2 __attribute__((ext_vector_type(2)));
__device__ __forceinline__ int lane_id() { int l; asm volatile("v_mbcnt_lo_u32_b32 %0, -1, 0\n\tv_mbcnt_hi_u32_b32 %0, -1, %0" : "=v"(l)); return l; }
template <class Epi, class Sched, bool ALIGN_EPI = false, bool SP2 = false>
__device__ __forceinline__ void gemm_phase(PG8_LAS unsigned char* lds, const Gemm g, const Sched& S, const Epi& E, int wave_in) {
    const int wid = __builtin_amdgcn_readfirstlane(wave_in), lane = lane_id(), tid = wid * 64 + lane, wr = wid >> 2, wc = wid & 3, fr = lane & 15, fq = lane >> 4;
    const int K = g.K, nt = K / BK;
    unsigned voffA[2], voffB[2];
#pragma unroll
    for (int i = 0; i < 2; ++i) { int R, C; stage_rc(tid * 16 + i * 8192, R, C); const int Rb = Epi::PERM ? ((R & ~31) + perm32(R & 31)) : R;
        voffA[i] = (unsigned)(R * K + C) * 2u; voffB[i] = (unsigned)(Rb * K + C) * 2u; }
    const size_t kstep = (size_t)(BK * 2);
    const size_t hstep = (size_t)HALF * K * 2;
    const size_t tstep = 2 * hstep;
    const unsigned ldsw = (unsigned)wid * 1024u;
    const int aoff = lds_byte(wr * 64 + fr, fq * 8), boff = lds_byte(wc * 32 + fr, fq * 8);
#define PG8_SA(b, h) (((b) * 2 + (h)) * HTB)
#define PG8_SB(b, h) ((4 + (b) * 2 + (h)) * HTB)
#define PG8_STAGE(bufoff, gbase, voff) do { _Pragma("unroll") for (int _i = 0; _i < 2; ++_i) \
        __builtin_amdgcn_global_load_lds((const unsigned*)((const char*)(gbase) + (voff)[_i]), (PG8_LAS unsigned*)(lds + (bufoff) + ldsw + _i * 8192), 16, 0, 0); } while (0)
#define PG8_LDA(dst, b, h) do { _Pragma("unroll") for (int m = 0; m < 4; ++m) _Pragma("unroll") for (int k = 0; k < 2; ++k) dst[m][k] = *(const PG8_LAS bf16x8*)(lds + PG8_SA(b, h) + aoff + m * 2048 + k * 1024); } while (0)
#define PG8_LDB(dst, b, h) do { _Pragma("unroll") for (int n = 0; n < 2; ++n) _Pragma("unroll") for (int k = 0; k < 2; ++k) dst[n][k] = *(const PG8_LAS bf16x8*)(lds + PG8_SB(b, h) + boff + n * 2048 + k * 1024); } while (0)
#define PG8_MMA(ai, bj, At, Bt) do { __builtin_amdgcn_s_setprio(1); _Pragma("unroll") for (int m = 0; m < 4; ++m) _Pragma("unroll") for (int n = 0; n < 2; ++n) _Pragma("unroll") for (int k = 0; k < 2; ++k) \
        acc[ai][bj][m][n] = __builtin_amdgcn_mfma_f32_16x16x32_bf16(Bt[n][k], At[m][k], acc[ai][bj][m][n], 0, 0, 0); __builtin_amdgcn_s_setprio(0); } while (0)
#define PG8_WAIT_V(n) asm volatile("s_waitcnt vmcnt(" #n ")" ::: "memory")
#define PG8_WAIT_L(n) asm volatile("s_waitcnt lgkmcnt(" #n ")" ::: "memory")
#define PG8_BAR __builtin_amdgcn_s_barrier()
#define PG8_SCHED __builtin_amdgcn_sched_barrier(0)
    Unit cur, nxt; int ui = 0;
    if (!S.next(0, cur)) return;
    f32x4 acc[2][2][4][2];
#pragma unroll
    for (int a = 0; a < 2; ++a)
#pragma unroll
        for (int b = 0; b < 2; ++b)
#pragma unroll
            for (int m = 0; m < 4; ++m)
#pragma unroll
                for (int n = 0; n < 2; ++n) acc[a][b][m][n] = (f32x4){0.f, 0.f, 0.f, 0.f};
    bf16x8 At[4][2], B0[2][2], B1[2][2];
    const char* cA = (const char*)g.A + (size_t)cur.pm * tstep; const char* cB = (const char*)g.Bt + (size_t)cur.pn * tstep;
    S.a_ready(cur);
    if constexpr (SP2) {
        PG8_STAGE(PG8_SB(0, 0), cB, voffB); PG8_STAGE(PG8_SB(0, 1), cB + hstep, voffB); PG8_STAGE(PG8_SA(0, 0), cA, voffA); PG8_STAGE(PG8_SA(0, 1), cA + hstep, voffA);
        if (wr == 1) PG8_BAR;
        PG8_WAIT_V(2); PG8_BAR;
        PG8_STAGE(PG8_SB(1, 0), cB + kstep, voffB); PG8_STAGE(PG8_SA(1, 0), cA + kstep, voffA); PG8_STAGE(PG8_SB(1, 1), cB + hstep + kstep, voffB);
        PG8_WAIT_V(6); PG8_BAR;
    } else {
        PG8_STAGE(PG8_SB(0, 0), cB, voffB); PG8_STAGE(PG8_SA(0, 0), cA, voffA); PG8_STAGE(PG8_SB(0, 1), cB + hstep, voffB); PG8_STAGE(PG8_SA(0, 1), cA + hstep, voffA);
        if (wr == 1) PG8_BAR;
        PG8_WAIT_V(4); PG8_BAR;
        PG8_STAGE(PG8_SB(1, 0), cB + kstep, voffB); PG8_STAGE(PG8_SA(1, 0), cA + kstep, voffA); PG8_STAGE(PG8_SB(1, 1), cB + hstep + kstep, voffB);
        PG8_WAIT_V(6); PG8_BAR;
    }
    for (;;) {
        const bool has_next = S.next(ui + 1, nxt);
        const char* nA = has_next ? (const char*)g.A + (size_t)nxt.pm * tstep : cA; const char* nB = has_next ? (const char*)g.Bt + (size_t)nxt.pn * tstep : cB;
        for (int t = 0; t < nt; t += 2) {
            const bool last = (t == nt - 2);
            const char* a1 = cA + (size_t)(t + 1) * kstep;
            const char* a2 = last ? nA : cA + (size_t)(t + 2) * kstep; const char* b2 = last ? nB : cB + (size_t)(t + 2) * kstep;
            const char* a3 = a2 + kstep; const char* b3 = b2 + kstep;
            if (last && has_next) S.a_ready(nxt);
            if constexpr (SP2) {
            PG8_LDB(B0, 0, 0); PG8_LDB(B1, 0, 1); PG8_SCHED; PG8_LDA(At, 0, 0); PG8_STAGE(PG8_SA(1, 1), a1 + hstep, voffA);
            PG8_WAIT_V(8); PG8_WAIT_L(0); PG8_BAR; PG8_MMA(0, 0, At, B0); PG8_MMA(0, 1, At, B1); PG8_BAR; PG8_SCHED;
            PG8_LDA(At, 0, 1); PG8_STAGE(PG8_SB(0, 0), b2, voffB); PG8_STAGE(PG8_SB(0, 1), b2 + hstep, voffB); PG8_STAGE(PG8_SA(0, 0), a2, voffA);
            PG8_WAIT_V(8); PG8_WAIT_L(0); PG8_BAR; PG8_MMA(1, 0, At, B0); PG8_MMA(1, 1, At, B1); PG8_BAR; PG8_SCHED;
            PG8_LDB(B0, 1, 0); PG8_LDB(B1, 1, 1); PG8_SCHED; PG8_LDA(At, 1, 0); PG8_STAGE(PG8_SA(0, 1), a2 + hstep, voffA);
            PG8_WAIT_V(8); PG8_WAIT_L(0); PG8_BAR; PG8_MMA(0, 0, At, B0); PG8_MMA(0, 1, At, B1); PG8_BAR; PG8_SCHED;
            PG8_LDA(At, 1, 1); PG8_STAGE(PG8_SB(1, 0), b3, voffB); PG8_STAGE(PG8_SB(1, 1), b3 + hstep, voffB); PG8_STAGE(PG8_SA(1, 0), a3, voffA);
            PG8_WAIT_V(8); PG8_WAIT_L(0); PG8_BAR; PG8_MMA(1, 0, At, B0); PG8_MMA(1, 1, At, B1); PG8_BAR; PG8_SCHED;
            } else {
            PG8_LDB(B0, 0, 0); PG8_SCHED; PG8_LDA(At, 0, 0); PG8_STAGE(PG8_SA(1, 1), a1 + hstep, voffA);
            PG8_WAIT_L(8); PG8_BAR; PG8_WAIT_L(0); PG8_MMA(0, 0, At, B0); PG8_BAR; PG8_SCHED;
            PG8_LDB(B1, 0, 1); PG8_STAGE(PG8_SB(0, 0), b2, voffB);
            PG8_BAR; PG8_WAIT_L(0); PG8_MMA(0, 1, At, B1); PG8_BAR;
            PG8_LDA(At, 0, 1); PG8_STAGE(PG8_SA(0, 0), a2, voffA);
            PG8_BAR; PG8_WAIT_L(0); PG8_MMA(1, 0, At, B0); PG8_BAR; PG8_SCHED;
            PG8_STAGE(PG8_SB(0, 1), b2 + hstep, voffB);
            PG8_WAIT_V(6); PG8_BAR; PG8_MMA(1, 1, At, B1); PG8_BAR;
            PG8_LDB(B0, 1, 0); PG8_SCHED; PG8_LDA(At, 1, 0); PG8_STAGE(PG8_SA(0, 1), a2 + hstep, voffA);
            PG8_WAIT_L(8); PG8_BAR; PG8_WAIT_L(0); PG8_MMA(0, 0, At, B0); PG8_BAR; PG8_SCHED;
            PG8_LDB(B1, 1, 1); PG8_STAGE(PG8_SB(1, 0), b3, voffB);
            PG8_BAR; PG8_WAIT_L(0); PG8_MMA(0, 1, At, B1); PG8_BAR;
            PG8_LDA(At, 1, 1); PG8_STAGE(PG8_SA(1, 0), a3, voffA);
            PG8_BAR; PG8_WAIT_L(0); PG8_MMA(1, 0, At, B0); PG8_BAR; PG8_SCHED;
            PG8_STAGE(PG8_SB(1, 1), b3 + hstep, voffB);
            PG8_WAIT_V(6); PG8_BAR; PG8_MMA(1, 1, At, B1); PG8_BAR;
            }
        }
        if constexpr (ALIGN_EPI) { if (wr == 0) PG8_BAR; }
        if constexpr (!Epi::AFTER_DRAIN) { E(acc, cur, wr, wc, fr, fq); S.done(cur); }
        if (!has_next) break;
#pragma unroll
        for (int a = 0; a < 2; ++a)
#pragma unroll
            for (int b = 0; b < 2; ++b)
#pragma unroll
                for (int m = 0; m < 4; ++m)
#pragma unroll
                    for (int n = 0; n < 2; ++n) acc[a][b][m][n] = (f32x4){0.f, 0.f, 0.f, 0.f};
        cur = nxt; cA = nA; cB = nB; ++ui;
        if constexpr (ALIGN_EPI) { if (wr == 1) PG8_BAR; }
    }
    PG8_WAIT_V(0);
    if constexpr (!ALIGN_EPI) { if (wr == 0) PG8_BAR; }
    PG8_BAR;
    if constexpr (Epi::AFTER_DRAIN) { E.fused(acc, cur, wr, wc, fr, fq, lds, wid, lane); S.done(cur); }
#undef PG8_SA
#undef PG8_SB
#undef PG8_STAGE
#undef PG8_LDA
#undef PG8_LDB
#undef PG8_MMA
#undef PG8_WAIT_V
#undef PG8_WAIT_L
#undef PG8_BAR
#undef PG8_SCHED
}
constexpr int OUT_KP = 34078720, OUT_VP = 34111488, OUT_PP = 34144256, OUT_KS = 34159616, OUT_VS = 34225152, OUT_PS = 34290688;
constexpr float QSCALE = 0.125f * 1.4426950408889634f;
constexpr float RMS_EPS = 1e-6f;

__device__ __forceinline__ u32x4 pack8(f32x4 v0, f32x4 v1) { u32x4 w; w.x = cvt_pk_bf16(v0[0], v0[1]); w.y = cvt_pk_bf16(v0[2], v0[3]); w.z = cvt_pk_bf16(v1[0], v1[1]); w.w = cvt_pk_bf16(v1[2], v1[3]); return w; }
__device__ __forceinline__ float bf_lo(unsigned w) { return __uint_as_float(w << 16); }
__device__ __forceinline__ float bf_hi(unsigned w) { return __uint_as_float(w & 0xffff0000u); }

struct EpiPlain {
    static constexpr bool PERM = true, AFTER_DRAIN = false;
    bf16_t* O; int ldc;
    __device__ __forceinline__ void operator()(const f32x4 (&acc)[2][2][4][2], const Unit& u, int wr, int wc, int fr, int fq) const {
        const int row0 = u.pm * BM + wr * 64 + fr, col0 = u.pn * BM + wc * 32 + 8 * fq;
#pragma unroll
        for (int ai = 0; ai < 2; ++ai)
#pragma unroll
            for (int m = 0; m < 4; ++m) { bf16_t* rowp = O + (size_t)(row0 + ai * HALF + m * 16) * ldc + col0;
#pragma unroll
                for (int bj = 0; bj < 2; ++bj) *(u32x4*)(rowp + bj * HALF) = pack8(acc[ai][bj][m][0], acc[ai][bj][m][1]); }
    }
};
struct EpiIn {
    static constexpr bool PERM = true, AFTER_DRAIN = false;
    bf16_t* Z; float* out;
    __device__ __forceinline__ void operator()(const f32x4 (&acc)[2][2][4][2], const Unit& u, int wr, int wc, int fr, int fq) const {
        const int row0 = u.pm * BM + wr * 64 + fr, col0 = u.pn * BM + wc * 32 + 8 * fq;
        const float sc = (u.pn < 2) ? QSCALE : 1.f;
#pragma unroll
        for (int ai = 0; ai < 2; ++ai)
#pragma unroll
            for (int m = 0; m < 4; ++m) { bf16_t* rowp = Z + (size_t)(row0 + ai * HALF + m * 16) * 1280 + col0;
#pragma unroll
                for (int bj = 0; bj < 2; ++bj) *(u32x4*)(rowp + bj * HALF) = pack8(acc[ai][bj][m][0] * sc, acc[ai][bj][m][1] * sc); }
        const bool special = (u.pn >= 2) && (u.pm == 63 || u.pm >= 127);
        if (special) {
#pragma unroll
            for (int ai = 0; ai < 2; ++ai)
#pragma unroll
                for (int m = 0; m < 4; ++m) { const int row = row0 + ai * HALF + m * 16;
#pragma unroll
                    for (int bj = 0; bj < 2; ++bj) { const int col = col0 + bj * HALF;
                        long dst = -1;
                        if (row < 32768) { const int b = row >> 14, t = row & 16383;
                            if (col < 640) { if (t >= 16256) dst = OUT_KP + (long)(b * 128 + (t - 16256)) * 128 + (col - 512); }
                            else if (col < 768) { if (t >= 16256) dst = OUT_VP + (long)(b * 128 + (t - 16256)) * 128 + (col - 640); }
                            else { if (t >= 16369) dst = OUT_PP + (long)(b * 15 + (t - 16369)) * 512 + (col - 768); }
                        } else { const int rs = row - 32768, b = rs >> 4, t = rs & 15;
                            if (col < 640) dst = OUT_KS + (long)rs * 128 + (col - 512);
                            else if (col < 768) dst = OUT_VS + (long)rs * 128 + (col - 640);
                            else { if (t >= 1) dst = OUT_PS + (long)(b * 15 + (t - 1)) * 512 + (col - 768); }
                        }
                        if (dst >= 0) { *(f32x4*)(out + dst) = acc[ai][bj][m][0]; *(f32x4*)(out + dst + 4) = acc[ai][bj][m][1]; } } }
        }
    }
};
template <bool FIRST> struct EpiRes {
    static constexpr bool PERM = true, AFTER_DRAIN = false;
    const float* xp; const float* xs; float* xo; bf16_t* xb; float* ssq;
    __device__ __forceinline__ void operator()(const f32x4 (&acc)[2][2][4][2], const Unit& u, int wr, int wc, int fr, int fq) const {
        const int row0 = u.pm * BM + wr * 64 + fr, col0 = u.pn * BM + wc * 32 + 8 * fq;
#pragma unroll
        for (int ai = 0; ai < 2; ++ai)
#pragma unroll
            for (int m = 0; m < 4; ++m) { const int row = row0 + ai * HALF + m * 16; const size_t off = (size_t)row * 1024 + col0;
                const float* src = FIRST ? (row < 32768 ? xp + off : xs + (off - (size_t)32768 * 1024)) : xo + off;
                float s = 0.f;
#pragma unroll
                for (int bj = 0; bj < 2; ++bj) { const f32x4 a0 = *(const f32x4*)(src + bj * HALF), a1 = *(const f32x4*)(src + bj * HALF + 4);
                    const f32x4 v0 = a0 + acc[ai][bj][m][0], v1 = a1 + acc[ai][bj][m][1];
                    *(f32x4*)(xo + off + bj * HALF) = v0; *(f32x4*)(xo + off + bj * HALF + 4) = v1;
                    *(u32x4*)(xb + off + bj * HALF) = pack8(v0, v1);
                    s += (v0[0] * v0[0] + v0[1] * v0[1]) + (v0[2] * v0[2] + v0[3] * v0[3]) + (v1[0] * v1[0] + v1[1] * v1[1]) + (v1[2] * v1[2] + v1[3] * v1[3]); }
                s += __shfl_xor(s, 16); s += __shfl_xor(s, 32);
                if (fq == 0) atomicAdd(ssq + row, s); }
    }
};
struct EpiUp {
    static constexpr bool PERM = true, AFTER_DRAIN = false;
    bf16_t* H; const float* ssq;
    __device__ __forceinline__ void operator()(const f32x4 (&acc)[2][2][4][2], const Unit& u, int wr, int wc, int fr, int fq) const {
        const int row0 = u.pm * BM + wr * 64 + fr, col0 = u.pn * BM + wc * 32 + 8 * fq;
#pragma unroll
        for (int ai = 0; ai < 2; ++ai)
#pragma unroll
            for (int m = 0; m < 4; ++m) { const int row = row0 + ai * HALF + m * 16; const float rs = rsqrtf(ssq[row] * (1.f / 1024.f) + RMS_EPS);
                bf16_t* rowp = H + (size_t)row * 4096 + col0;
#pragma unroll
                for (int bj = 0; bj < 2; ++bj) { f32x4 v0 = acc[ai][bj][m][0] * rs, v1 = acc[ai][bj][m][1] * rs;
#pragma unroll
                    for (int e = 0; e < 4; ++e) { const float a = fmaxf(v0[e], 0.f), b = fmaxf(v1[e], 0.f); v0[e] = a * a; v1[e] = b * b; }
                    *(u32x4*)(rowp + bj * HALF) = pack8(v0, v1); } }
    }
};
struct EpiGate {
    static constexpr bool PERM = true, AFTER_DRAIN = false;
    float* xo; const bf16_t* pp; const float* ssq_in; float* ssq_out;
    __device__ __forceinline__ void operator()(const f32x4 (&acc)[2][2][4][2], const Unit& u, int wr, int wc, int fr, int fq) const {
        const int row0 = u.pm * BM + wr * 64 + fr, col0 = u.pn * BM + wc * 32 + 8 * fq;
#pragma unroll
        for (int ai = 0; ai < 2; ++ai)
#pragma unroll
            for (int m = 0; m < 4; ++m) { const int row = row0 + ai * HALF + m * 16; const size_t off = (size_t)row * 1024 + col0;
                const float rs = rsqrtf(ssq_in[row] * (1.f / 1024.f) + RMS_EPS) * (-1.4426950408889634f);
                float s = 0.f;
#pragma unroll
                for (int bj = 0; bj < 2; ++bj) { const f32x4 a0 = *(const f32x4*)(xo + off + bj * HALF), a1 = *(const f32x4*)(xo + off + bj * HALF + 4);
                    const u32x4 pw = *(const u32x4*)(pp + off + bj * HALF);
                    const f32x4 p0 = (f32x4){bf_lo(pw.x), bf_hi(pw.x), bf_lo(pw.y), bf_hi(pw.y)}, p1 = (f32x4){bf_lo(pw.z), bf_hi(pw.z), bf_lo(pw.w), bf_hi(pw.w)};
                    f32x4 v0, v1;
#pragma unroll
                    for (int e = 0; e < 4; ++e) { const float g0 = __builtin_amdgcn_rcpf(1.f + __builtin_amdgcn_exp2f(acc[ai][bj][m][0][e] * rs)), g1 = __builtin_amdgcn_rcpf(1.f + __builtin_amdgcn_exp2f(acc[ai][bj][m][1][e] * rs));
                        v0[e] = a0[e] + g0 * p0[e]; v1[e] = a1[e] + g1 * p1[e]; }
                    *(f32x4*)(xo + off + bj * HALF) = v0; *(f32x4*)(xo + off + bj * HALF + 4) = v1;
                    s += (v0[0] * v0[0] + v0[1] * v0[1]) + (v0[2] * v0[2] + v0[3] * v0[3]) + (v1[0] * v1[0] + v1[1] * v1[1]) + (v1[2] * v1[2] + v1[3] * v1[3]); }
                s += __shfl_xor(s, 16); s += __shfl_xor(s, 32);
                if (fq == 0) atomicAdd(ssq_out + row, s); }
    }
};
}
constexpr int NWAVES = 8;
constexpr int MP = 32768, MS = 512, M = MP + MS;
constexpr int D = 1024, NIN = 1280, FF = 4096, PLE = 256, SEQ = 16384;
#ifndef MK_N_LAUNCHES
#define MK_N_LAUNCHES 1
#endif
constexpr int N_PHASES = 8;
constexpr size_t MiB = 1u << 20;
constexpr size_t WS_CTL = 0, CTL_ZERO_BYTES = 1 * MiB;
constexpr size_t WS_SSQ1 = 0, WS_SSQ2 = 160 * 1024, WS_SSQ3 = 320 * 1024, WS_BAR = 512 * 1024;
constexpr size_t WS_WIN = 1 * MiB;
constexpr size_t WS_WO = 4 * MiB;
constexpr size_t WS_WUP = 6 * MiB;
constexpr size_t WS_WD = 14 * MiB;
constexpr size_t WS_WG = 22 * MiB;
constexpr size_t WS_WPLE = 24 * MiB;
constexpr size_t WS_WPOOL = 24 * MiB + 512 * 1024;
constexpr size_t WS_PLEB = 26 * MiB;
constexpr size_t WS_PP = 43 * MiB;
constexpr size_t WS_XB = 108 * MiB;
constexpr size_t WS_H = 173 * MiB;
constexpr size_t WS_Z = 173 * MiB;
constexpr size_t WS_MIX = 255 * MiB;
constexpr size_t WS_END = 433 * MiB;
static_assert(WS_Z + (size_t)M * NIN * 2 <= WS_MIX && WS_MIX + (size_t)M * D * 2 <= WS_END && WS_H + (size_t)M * FF * 2 <= WS_END && WS_XB + (size_t)M * D * 2 <= WS_H && WS_PP + (size_t)M * D * 2 <= WS_XB && WS_PLEB + (size_t)M * PLE * 2 <= WS_PP, "d_ws map");
constexpr int LDS_BYTES = 147456;
constexpr int MISC_OFF = 140 * 1024;
#define GAS __attribute__((address_space(1)))
#define LAS __attribute__((address_space(3)))
typedef unsigned short bf16;
typedef unsigned v4u __attribute__((ext_vector_type(4)));
typedef unsigned v2u __attribute__((ext_vector_type(2)));
typedef float f32x4 __attribute__((ext_vector_type(4)));
typedef float f32x16 __attribute__((ext_vector_type(16)));
typedef short bf16x8 __attribute__((ext_vector_type(8)));
typedef short s16x4 __attribute__((ext_vector_type(4)));
#define LDS_WAIT() asm volatile("s_waitcnt lgkmcnt(0)" ::: "memory")
__device__ __forceinline__ unsigned f2bf(float f) { unsigned u = __builtin_bit_cast(unsigned, f); return (u + 0x7fffu + ((u >> 16) & 1u)) >> 16; }
__device__ __forceinline__ unsigned pk2(float lo, float hi) { return f2bf(lo) | (f2bf(hi) << 16); }
__device__ __forceinline__ float bflo(unsigned w) { return __uint_as_float(w << 16); }
__device__ __forceinline__ float bfhi(unsigned w) { return __uint_as_float(w & 0xffff0000u); }
__device__ __forceinline__ float wave_sum(float v) {
#pragma unroll
    for (int o = 1; o < 64; o <<= 1) v += __shfl_xor(v, o);
    return v;
}

#define RLX_AGENT __ATOMIC_RELAXED, __HIP_MEMORY_SCOPE_AGENT
#define XB_TMO      128
#define XB_XCNT(j)  (256  + 64 * (j))
#define XB_XSUB(j)  (1280 + 64 * (j))
#define XB_XGEN(j)  (2304 + 64 * (j))
#define XB_TOP      3328
#define XB_TOPGEN   3392
#define XCD_BAR_WORDS 3456
#define XB_SPIN_CAP (1u << 18)

__device__ __forceinline__ unsigned xb_ld(unsigned* p)              { return __hip_atomic_load(p, __ATOMIC_RELAXED, __HIP_MEMORY_SCOPE_AGENT); }
__device__ __forceinline__ unsigned xb_add(unsigned* p, unsigned v) { return __hip_atomic_fetch_add(p, v, __ATOMIC_RELAXED, __HIP_MEMORY_SCOPE_AGENT); }
__device__ __forceinline__ unsigned xb_xcc_id() { return (unsigned)__builtin_amdgcn_s_getreg((3 << 11) | 20) & 0xFu; }
#define XB_SPIN(cond, bar) do { unsigned _sp = 0; while (cond) { __builtin_amdgcn_s_sleep(1); \
    if ((++_sp & 255u) == 0u) { if (xb_ld(&(bar)[XB_TMO])) break; if (_sp > XB_SPIN_CAP) { atomicAdd(&(bar)[XB_TMO], 1u); break; } } } } while (0)

struct XcdBarrier {
    unsigned* bar; unsigned x;
    volatile LAS unsigned* st;
};

__device__ __forceinline__ XcdBarrier xcd_barrier_post(unsigned* bar, volatile LAS unsigned* st, bool leader) {
    XcdBarrier b; b.bar = bar; b.x = xb_xcc_id(); b.st = st;
    if (leader) (void)xb_add(&bar[XB_XCNT(b.x)], 1u);
    return b;
}
__device__ __forceinline__ void xcd_barrier_complete(unsigned* bar, unsigned x, unsigned& nloc, unsigned& nx) {
    const unsigned G = gridDim.x * gridDim.y * gridDim.z;
    unsigned sum, cnt, mine, sp = 0u;
    for (;;) {
        sum = 0u; cnt = 0u; mine = 0u;
#pragma unroll
        for (unsigned j = 0; j < 16; ++j) { const unsigned c = xb_ld(&bar[XB_XCNT(j)]); sum += c; cnt += (c > 0u) ? 1u : 0u; mine = (j == x) ? c : mine; }
        if (sum == G) break;
        __builtin_amdgcn_s_sleep(1);
        if ((++sp & 255u) == 0u) { if (xb_ld(&bar[XB_TMO])) break; if (sp > XB_SPIN_CAP) { atomicAdd(&bar[XB_TMO], 1u); break; } }
    }
    nloc = mine > 0u ? mine : 1u; nx = cnt > 0u ? cnt : 1u;
}

__device__ __forceinline__ void xcd_barrier(const XcdBarrier& b, bool leader) {
    asm volatile("s_waitcnt vmcnt(0)" ::: "memory");
    __syncthreads();
    if (leader) {
        unsigned* bar = b.bar;
        __builtin_amdgcn_s_waitcnt(0);
        unsigned nloc = b.st[0], nx = b.st[1];
        if (nloc == 0u) { xcd_barrier_complete(bar, b.x, nloc, nx); b.st[0] = nloc; b.st[1] = nx; }
        const unsigned old = xb_add(&bar[XB_XSUB(b.x)], 1u);
        const unsigned gen = old / nloc;
        if (old + 1u == (gen + 1u) * nloc) {
            __builtin_amdgcn_fence(__ATOMIC_RELEASE, "agent");
            asm volatile("s_waitcnt vmcnt(0)" ::: "memory");
            const unsigned og = xb_add(&bar[XB_TOP], 1u);
            const unsigned tg = og / nx;
            if (og + 1u == (tg + 1u) * nx) xb_add(&bar[XB_TOPGEN], 1u);
            else XB_SPIN(xb_ld(&bar[XB_TOPGEN]) == tg, bar);
            __builtin_amdgcn_fence(__ATOMIC_ACQUIRE, "agent");
            xb_add(&bar[XB_XGEN(b.x)], 1u);
            asm volatile("s_waitcnt vmcnt(0)" ::: "memory");
        } else {
            XB_SPIN(xb_ld(&bar[XB_XGEN(b.x)]) == gen, bar);
            __builtin_amdgcn_fence(__ATOMIC_ACQUIRE, "agent");
            asm volatile("s_waitcnt vmcnt(0)" ::: "memory");
        }
    }
    __syncthreads();
}

struct Params { const float* in[22]; float* out; unsigned char* ws; int ph_lo, ph_hi; };
struct Frame { LAS unsigned char* lds; int tid, lane, wave, vcu, G; };
#define FRAME_LANES(F) do { (F).lane = pg8::lane_id(); (F).tid = (F).wave * 64 + (F).lane; } while (0)
typedef const __attribute__((address_space(4))) Params* KPtr;
__device__ __forceinline__ KPtr kparams() { KPtr k = (KPtr)__builtin_amdgcn_kernarg_segment_ptr(); asm volatile("" : "+s"(k)); return k; }

__device__ __forceinline__ void p0_transpose_item(const float* W, const float* g, int K, int N, bf16* WT, LAS float* scr, int item, int lane) {
    const int nblk = N / 32, kb = item / nblk, nb = item % nblk, k0 = 64 * kb, n0 = 32 * nb;
#pragma unroll 8
    for (int i = 0; i < 32; ++i) { const int kk = 2 * i + (lane >> 5); const float gv = g ? g[k0 + kk] : 1.f; scr[kk * 33 + (lane & 31)] = W[(size_t)(k0 + kk) * N + n0 + (lane & 31)] * gv; }
    LDS_WAIT(); asm volatile("" ::: "memory");
    const int c = lane & 7;
#pragma unroll
    for (int j = 0; j < 4; ++j) { const int n = (lane >> 3) + 8 * j; const LAS float* s = scr + (8 * c) * 33 + n;
        v4u o; o.x = pk2(s[0 * 33], s[1 * 33]); o.y = pk2(s[2 * 33], s[3 * 33]); o.z = pk2(s[4 * 33], s[5 * 33]); o.w = pk2(s[6 * 33], s[7 * 33]);
        *(GAS v4u*)(WT + (size_t)(n0 + n) * K + k0 + 8 * c) = o; }
    LDS_WAIT(); asm volatile("" ::: "memory");
}
__device__ __forceinline__ void p0_prologue(const Frame& F, KPtr P) {
    LAS float* scr = (LAS float*)(F.lds + F.wave * 16384);
    const int gw = F.vcu * NWAVES + F.wave, NGW = F.G * NWAVES;
    unsigned char* ws = P->ws;
    constexpr int I_IN = 16 * 40, I_O = 16 * 32, I_UP = 16 * 128, I_D = 64 * 32, I_G = 16 * 32, I_PLE = 4 * 32, I_POOL = 4 * 8;
    constexpr int NITEMS = I_IN + I_O + I_UP + I_D + I_G + I_PLE + I_POOL;
    for (int it = gw; it < NITEMS; it += NGW) {
        int r = it;
        if (r < I_UP) { p0_transpose_item(P->in[16], P->in[15], D, FF, (bf16*)(ws + WS_WUP), scr, r, F.lane); continue; } r -= I_UP;
        if (r < I_D) { p0_transpose_item(P->in[17], nullptr, FF, D, (bf16*)(ws + WS_WD), scr, r, F.lane); continue; } r -= I_D;
        if (r < I_IN) { p0_transpose_item(P->in[8], nullptr, D, NIN, (bf16*)(ws + WS_WIN), scr, r, F.lane); continue; } r -= I_IN;
        if (r < I_O) { p0_transpose_item(P->in[14], nullptr, D, D, (bf16*)(ws + WS_WO), scr, r, F.lane); continue; } r -= I_O;
        if (r < I_G) { p0_transpose_item(P->in[19], P->in[18], D, D, (bf16*)(ws + WS_WG), scr, r, F.lane); continue; } r -= I_G;
        if (r < I_PLE) { p0_transpose_item(P->in[20], nullptr, PLE, D, (bf16*)(ws + WS_WPLE), scr, r, F.lane); continue; } r -= I_PLE;
        { const int g = r >> 3; p0_transpose_item(P->in[11] + g * 16384, nullptr, 128, 128, (bf16*)(ws + WS_WPOOL) + g * 16384, scr, r & 7, F.lane); }
    }
    const float* lnm = P->in[7];
    f32x4 gv[4];
#pragma unroll
    for (int j = 0; j < 4; ++j) gv[j] = ((const f32x4*)lnm)[F.lane + 64 * j];
    bf16* XN = (bf16*)(ws + WS_XB);
    for (int m = gw; m < M; m += NGW) {
        const float* xrow = (m < MP) ? P->in[0] + (size_t)m * D : P->in[1] + (size_t)(m - MP) * D;
        const GAS f32x4* xr = (const GAS f32x4*)xrow + F.lane;
        f32x4 v[4]; float s = 0.f;
#pragma unroll
        for (int j = 0; j < 4; ++j) { v[j] = xr[64 * j]; s += (v[j].x * v[j].x + v[j].y * v[j].y) + (v[j].z * v[j].z + v[j].w * v[j].w); }
        const float rstd = rsqrtf(wave_sum(s) * (1.f / D) + pg8::RMS_EPS);
        GAS v2u* o8 = (GAS v2u*)(XN + (size_t)m * D) + F.lane;
#pragma unroll
        for (int j = 0; j < 4; ++j) { v2u o; o.x = pk2(v[j].x * rstd * gv[j].x, v[j].y * rstd * gv[j].y); o.y = pk2(v[j].z * rstd * gv[j].z, v[j].w * rstd * gv[j].w); o8[64 * j] = o; }
    }
    bf16* PB = (bf16*)(ws + WS_PLEB);
    for (int m = gw; m < M; m += NGW) {
        const float* prow = (m < MP) ? P->in[5] + (size_t)m * PLE : P->in[6] + (size_t)(m - MP) * PLE;
        const f32x4 v = ((const GAS f32x4*)prow)[F.lane];
        v2u o; o.x = pk2(v.x, v.y); o.y = pk2(v.z, v.w);
        ((GAS v2u*)(PB + (size_t)m * PLE))[F.lane] = o;
    }
}

constexpr int KSB = 272;
constexpr int L_K = 0, L_V = 192 * KSB, L_U = 0, USB = 1040  , L_SCR = 120 * 1024;
static_assert(2 * 192 * KSB <= L_SCR && 79 * USB <= L_SCR, "P2 LDS map");
__device__ __forceinline__ int crow(int r, int hi) { return (r & 3) + 8 * (r >> 2) + 4 * hi; }
__device__ __forceinline__ bf16x8 pack_step(const f32x16& x, int s) {
    v4u p; p.x = pg8::cvt_pk_bf16(x[8 * s], x[8 * s + 1]); p.y = pg8::cvt_pk_bf16(x[8 * s + 2], x[8 * s + 3]); p.z = pg8::cvt_pk_bf16(x[8 * s + 4], x[8 * s + 5]); p.w = pg8::cvt_pk_bf16(x[8 * s + 6], x[8 * s + 7]);
    return __builtin_bit_cast(bf16x8, p);
}
typedef short v4i16_t __attribute__((ext_vector_type(4)));
__device__ __forceinline__ s16x4 vtr(const LAS unsigned char* p) { return __builtin_bit_cast(s16x4, __builtin_amdgcn_ds_read_tr16_b64_v4i16((LAS v4i16_t*)p)); }

__device__ __forceinline__ void mix_unit(const Frame& F, KPtr P, int unit) {
    unsigned char* ws = P->ws;
    const bf16* Z = (const bf16*)(ws + WS_Z);
    bf16* MIX = (bf16*)(ws + WS_MIX);
    const int tid = F.tid, lane = F.lane, wave = F.wave, r32 = lane & 31, hi = lane >> 5;
    LAS unsigned char* lds = F.lds;
    const bool prompt = unit < 512;
    int qrow0, nq, kmin, kmax, pos0, sb = 0;
    if (prompt) { const int b = unit >> 8, c = unit & 255; qrow0 = b * SEQ + c * 64; nq = 64; kmin = (c >= 2) ? 0 : (2 - c) * 64; kmax = 192; pos0 = c * 64; }
    else { sb = unit - 512; qrow0 = MP + sb * 16; nq = 16; kmin = 0; kmax = 144; pos0 = 2048; }
    const int nqt = (nq + 31) >> 5;
    for (int p = tid; p < 192 * 32; p += NWAVES * 64) {
        const int row = p >> 5, cp = p & 31;
        v4u val = (v4u){0u, 0u, 0u, 0u};
        if (row >= kmin && row < kmax) {
            if (prompt) val = *(const GAS v4u*)(Z + (size_t)(qrow0 - 128 + row) * NIN + 512 + cp * 8);
            else if (row >= 128) val = *(const GAS v4u*)(Z + (size_t)(qrow0 + row - 128) * NIN + 512 + cp * 8);
            else { const float* src = ((cp < 16) ? P->in[2] : P->in[3]) + (size_t)(sb * 128 + row) * 128 + (cp & 15) * 8;
                const f32x4 a = *(const GAS f32x4*)src, b2 = *(const GAS f32x4*)(src + 4);
                val.x = pk2(a.x, a.y); val.y = pk2(a.z, a.w); val.z = pk2(b2.x, b2.y); val.w = pk2(b2.z, b2.w); }
        }
        *(LAS v4u*)(lds + ((cp < 16) ? L_K : L_V) + row * KSB + (cp & 15) * 16) = val;
    }
    __syncthreads();
    const int hd = wave, kvh = wave >> 2;
    const float sink2 = P->in[9][hd] * 1.4426950408889634f;
    LAS float* scr = (LAS float*)(lds + L_SCR);
    float biasv[6][2];
#pragma unroll
    for (int j = 0; j < 6; ++j)
#pragma unroll
        for (int rh = 0; rh < 2; ++rh) { const int k0 = 32 * j + 16 * rh; biasv[j][rh] = (k0 >= kmin && k0 < kmax) ? 0.f : -INFINITY; }
    const float* ga = P->in[10];
#ifndef NO_ATT
#pragma unroll 1
    for (int qt = 0; qt < nqt; ++qt) {
        f32x16 o[2];
#pragma unroll
        for (int db = 0; db < 2; ++db)
#pragma unroll
            for (int r = 0; r < 16; ++r) o[db][r] = 0.f;
        const int ql = 32 * qt + r32; const int qrow = qrow0 + (ql < nq ? ql : 0);
        bf16x8 qr[4];
#pragma unroll
        for (int ds = 0; ds < 4; ++ds) qr[ds] = *(const GAS bf16x8*)(Z + (size_t)qrow * NIN + hd * 64 + ds * 16 + hi * 8);
        float mx = sink2;
#pragma unroll
        for (int j = 0; j < 6; ++j) {
            f32x16 T;
#pragma unroll
            for (int r = 0; r < 16; ++r) T[r] = biasv[j][r >> 3];
#pragma unroll
            for (int ds = 0; ds < 4; ++ds) { const bf16x8 kf = *(const LAS bf16x8*)(lds + L_K + (32 * j + r32) * KSB + (kvh * 64 + ds * 16 + hi * 8) * 2);
                T = __builtin_amdgcn_mfma_f32_32x32x16_bf16(kf, qr[ds], T, 0, 0, 0); }
#pragma unroll
            for (int r = 0; r < 16; ++r) mx = fmaxf(mx, T[r]);
        }
        mx = fmaxf(mx, __shfl_xor(mx, 32));
        float ls = 0.f;
        const int i16 = lane & 15, qd = i16 >> 2, pp4 = i16 & 3, blk = (lane >> 4) & 1;
        const LAS unsigned char* vbase = lds + L_V + (4 * hi + qd) * KSB + (kvh * 64 + 16 * blk + 4 * pp4) * 2;
#pragma unroll
        for (int j = 0; j < 6; ++j) {
            f32x16 T;
#pragma unroll
            for (int r = 0; r < 16; ++r) T[r] = biasv[j][r >> 3] - mx;
#pragma unroll
            for (int ds = 0; ds < 4; ++ds) { const bf16x8 kf = *(const LAS bf16x8*)(lds + L_K + (32 * j + r32) * KSB + (kvh * 64 + ds * 16 + hi * 8) * 2);
                T = __builtin_amdgcn_mfma_f32_32x32x16_bf16(kf, qr[ds], T, 0, 0, 0); }
#pragma unroll
            for (int r = 0; r < 16; ++r) { T[r] = __builtin_amdgcn_exp2f(T[r]); ls += T[r]; }
#pragma unroll
            for (int s = 0; s < 2; ++s) { const bf16x8 pf = pack_step(T, s);
#pragma unroll
                for (int db = 0; db < 2; ++db) { const LAS unsigned char* vp = vbase + (32 * j + 16 * s) * KSB + 64 * db;
                    const s16x4 lo = vtr(vp), hi4 = vtr(vp + 8 * KSB);
                    const bf16x8 vf = __builtin_shufflevector(lo, hi4, 0, 1, 2, 3, 4, 5, 6, 7);
                    o[db] = __builtin_amdgcn_mfma_f32_32x32x16_bf16(vf, pf, o[db], 0, 0, 0); } }
        }
        ls += __shfl_xor(ls, 32);
        const float inv = 1.f / (ls + __builtin_amdgcn_exp2f(sink2 - mx));
        float sq = 0.f;
#pragma unroll
        for (int db = 0; db < 2; ++db)
#pragma unroll
            for (int r = 0; r < 16; ++r) { o[db][r] *= inv; sq += o[db][r] * o[db][r]; }
        sq += __shfl_xor(sq, 32);
        if (hi == 0) scr[wave * 32 + r32] = sq;
        __syncthreads();
        float tot = 0.f;
#pragma unroll
        for (int w = 0; w < 8; ++w) tot += scr[w * 32 + r32];
        const float rstd = rsqrtf(tot * (1.f / 512.f) + pg8::RMS_EPS);
        if (ql < nq) { bf16* orow = MIX + (size_t)(qrow0 + ql) * D + hd * 64;
#pragma unroll
            for (int db = 0; db < 2; ++db)
#pragma unroll
                for (int rg = 0; rg < 4; ++rg) { const int d0 = 32 * db + 8 * rg + 4 * hi; const f32x4 g = *(const f32x4*)(ga + hd * 64 + d0);
                    v2u w; w.x = pk2(o[db][4 * rg] * rstd * g.x, o[db][4 * rg + 1] * rstd * g.y); w.y = pk2(o[db][4 * rg + 2] * rstd * g.z, o[db][4 * rg + 3] * rstd * g.w);
                    *(GAS v2u*)(orow + d0) = w; } }
        __syncthreads();
    }
#endif
#ifndef NO_POOL
    for (int p = tid; p < 79 * 64; p += NWAVES * 64) {
        const int i = p >> 6, cp = p & 63;
        v4u val = (v4u){0u, 0u, 0u, 0u};
        if (i < 15 + nq) {
            if (i >= 15) val = *(const GAS v4u*)(Z + (size_t)(qrow0 + i - 15) * NIN + 768 + cp * 8);
            else if (prompt) { if (pos0 > 0) val = *(const GAS v4u*)(Z + (size_t)(qrow0 + i - 15) * NIN + 768 + cp * 8); }
            else { const float* src = P->in[4] + (size_t)(sb * 15 + i) * 512 + cp * 8; const f32x4 a = *(const GAS f32x4*)src, b2 = *(const GAS f32x4*)(src + 4);
                val.x = pk2(a.x, a.y); val.y = pk2(a.z, a.w); val.z = pk2(b2.x, b2.y); val.w = pk2(b2.z, b2.w); }
        }
        *(LAS v4u*)(lds + L_U + i * USB + cp * 16) = val;
    }
    __syncthreads();
    {
        const int g = wave >> 1, eh = wave & 1, w = 2 << g;
        const bf16* WpT = (const bf16*)(ws + WS_WPOOL) + g * 16384;
        const float* psc = P->in[12]; const float* gp = P->in[13];
        f32x16 bacc[2][2];
        float ssqb[2];
#pragma unroll
        for (int tt = 0; tt < 2; ++tt) {
            ssqb[tt] = 0.f;
#pragma unroll
            for (int et = 0; et < 2; ++et)
#pragma unroll
                for (int r = 0; r < 16; ++r) bacc[tt][et][r] = 0.f;
            if (tt < nqt) {
                const int t = 32 * tt + r32;
                const int pc = pos0 + t + 1; const float icnt = 1.f / (float)(pc < w ? pc : w);
#pragma unroll 2
                for (int ks = 0; ks < 8; ++ks) {
                    const int c = g * 128 + 16 * ks + 8 * hi;
                    const LAS unsigned char* up = lds + L_U + (15 + t) * USB + c * 2;
                    float sum[8];
#pragma unroll
                    for (int e = 0; e < 8; ++e) sum[e] = 0.f;
                    for (int i = 0; i < w; ++i) { const v4u x = *(const LAS v4u*)(up - i * USB);
                        sum[0] += bflo(x.x); sum[1] += bfhi(x.x); sum[2] += bflo(x.y); sum[3] += bfhi(x.y); sum[4] += bflo(x.z); sum[5] += bfhi(x.z); sum[6] += bflo(x.w); sum[7] += bfhi(x.w); }
                    const v4u x0 = *(const LAS v4u*)up;
                    v4u dv; dv.x = pk2(sum[0] * icnt - bflo(x0.x), sum[1] * icnt - bfhi(x0.x)); dv.y = pk2(sum[2] * icnt - bflo(x0.y), sum[3] * icnt - bfhi(x0.y));
                    dv.z = pk2(sum[4] * icnt - bflo(x0.z), sum[5] * icnt - bfhi(x0.z)); dv.w = pk2(sum[6] * icnt - bflo(x0.w), sum[7] * icnt - bfhi(x0.w));
                    const bf16x8 df = __builtin_bit_cast(bf16x8, dv);
#pragma unroll
                    for (int et = 0; et < 2; ++et) { const bf16x8 wf = *(const GAS bf16x8*)(WpT + (size_t)(64 * eh + 32 * et + r32) * 128 + 16 * ks + 8 * hi);
                        bacc[tt][et] = __builtin_amdgcn_mfma_f32_32x32x16_bf16(wf, df, bacc[tt][et], 0, 0, 0); }
                }
                float sq = 0.f;
#pragma unroll
                for (int et = 0; et < 2; ++et)
#pragma unroll
                    for (int rg = 0; rg < 4; ++rg) { const f32x4 sc = *(const f32x4*)(psc + g * 128 + 64 * eh + 32 * et + 8 * rg + 4 * hi);
#pragma unroll
                        for (int e = 0; e < 4; ++e) { const float v = bacc[tt][et][4 * rg + e] * sc[e]; bacc[tt][et][4 * rg + e] = v; sq += v * v; } }
                sq += __shfl_xor(sq, 32);
                ssqb[tt] = sq;
            }
        }
        if (hi == 0) { scr[512 + (0 * 8 + wave) * 32 + r32] = ssqb[0]; scr[512 + (1 * 8 + wave) * 32 + r32] = ssqb[1]; }
        __syncthreads();
#pragma unroll
        for (int tt = 0; tt < 2; ++tt) if (tt < nqt) {
            float tot = 0.f;
#pragma unroll
            for (int w2 = 0; w2 < 8; ++w2) tot += scr[512 + (tt * 8 + w2) * 32 + r32];
            const float rstd = rsqrtf(tot * (1.f / 512.f) + pg8::RMS_EPS);
            const int t = 32 * tt + r32;
            if (t < nq) { bf16* orow = MIX + (size_t)(qrow0 + t) * D + 512 + g * 128 + 64 * eh;
#pragma unroll
                for (int et = 0; et < 2; ++et)
#pragma unroll
                    for (int rg = 0; rg < 4; ++rg) { const int e0 = 32 * et + 8 * rg + 4 * hi; const f32x4 gg = *(const f32x4*)(gp + g * 128 + 64 * eh + e0);
                        v2u wv; wv.x = pk2(bacc[tt][et][4 * rg] * rstd * gg.x, bacc[tt][et][4 * rg + 1] * rstd * gg.y); wv.y = pk2(bacc[tt][et][4 * rg + 2] * rstd * gg.z, bacc[tt][et][4 * rg + 3] * rstd * gg.w);
                        *(GAS v2u*)(orow + e0) = wv; } }
        }
    }
    __syncthreads();
#endif
}

__device__ __forceinline__ void p7_final(const Frame& F, KPtr P) {
    const int gw = F.vcu * NWAVES + F.wave, NGW = F.G * NWAVES;
    const float* ssq3 = (const float*)(P->ws + WS_SSQ3); const float* gf = P->in[21];
    f32x4 gv[4];
#pragma unroll
    for (int j = 0; j < 4; ++j) gv[j] = ((const f32x4*)gf)[F.lane + 64 * j];
    for (int m = gw; m < M; m += NGW) {
        GAS f32x4* xr = (GAS f32x4*)(P->out + (size_t)m * D) + F.lane;
        const float rstd = rsqrtf(ssq3[m] * (1.f / D) + pg8::RMS_EPS);
#pragma unroll
        for (int j = 0; j < 4; ++j) { f32x4 v = xr[64 * j]; v = v * rstd * gv[j]; xr[64 * j] = v; }
    }
}

__global__ void __launch_bounds__(NWAVES * 64, 2) trunk_fwd(Params Pv) {
    extern __shared__ __attribute__((aligned(16))) unsigned char lds[];
    Frame F;
    F.lds = (LAS unsigned char*)lds;
    { int t_ = (int)threadIdx.x; asm volatile("" : "+v"(t_)); F.wave = __builtin_amdgcn_readfirstlane(t_ >> 6); } F.tid = 0; F.lane = 0;
    F.G = gridDim.x; { const int bx = blockIdx.x; F.vcu = (F.G % 8 == 0) ? (bx % 8) * (F.G / 8) + bx / 8 : bx; }
    unsigned char* ws = kparams()->ws;
    const int lo = kparams()->ph_lo, hi = kparams()->ph_hi;
#ifndef PHASE_MASK
#define PHASE_MASK 255
#endif
#define IN(k) (((PHASE_MASK >> (k)) & 1) && lo <= (k) && (k) < hi)
    volatile LAS unsigned* MISC = (volatile LAS unsigned*)(F.lds + MISC_OFF);
    if (pg8::lane_id() < 2 && F.wave == 0) MISC[pg8::lane_id()] = 0u;
    __syncthreads();
    XcdBarrier bar; bar.bar = (unsigned*)(ws + WS_BAR); bar.x = 0; bar.st = MISC;
    if (hi - lo > 2) bar = xcd_barrier_post((unsigned*)(ws + WS_BAR), MISC, F.wave == 0 && pg8::lane_id() == 0);
#define SEAM(k) do { if (IN(k) && IN((k) + 1)) { if ((k) == 0) cg::this_grid().sync(); else xcd_barrier(bar, F.wave == 0 && pg8::lane_id() == 0); } } while (0)
    float* ssq1 = (float*)(ws + WS_SSQ1); float* ssq2 = (float*)(ws + WS_SSQ2); float* ssq3 = (float*)(ws + WS_SSQ3);
    bf16* XB = (bf16*)(ws + WS_XB);

    if (IN(0)) { FRAME_LANES(F); p0_prologue(F, kparams()); }
    SEAM(0);
    if (IN(1)) {
        { pg8::Gemm g{XB, (const bf16*)(ws + WS_WIN), M, NIN, D}; pg8::StaticOrder S; S.init(M, NIN, F.G, (int)blockIdx.x);
          pg8::EpiIn E{(bf16*)(ws + WS_Z), kparams()->out};
          pg8::gemm_phase<pg8::EpiIn, pg8::StaticOrder, true, true>(F.lds, g, S, E, F.wave); }
        { pg8::Gemm g{(const bf16*)(ws + WS_PLEB), (const bf16*)(ws + WS_WPLE), M, D, PLE}; pg8::StaticOrder S; S.init(M, D, F.G, (int)blockIdx.x);
          pg8::EpiPlain E{(bf16*)(ws + WS_PP), D};
          pg8::gemm_phase<pg8::EpiPlain, pg8::StaticOrder, true, true>(F.lds, g, S, E, F.wave); }
    }
    SEAM(1);
    if (IN(2)) {
        FRAME_LANES(F); for (int u = F.vcu; u < 544; u += F.G) mix_unit(F, kparams(), u);
    }
    SEAM(2);
    if (IN(3)) {
        pg8::Gemm g{(const bf16*)(ws + WS_MIX), (const bf16*)(ws + WS_WO), M, D, D}; pg8::StaticOrder S; S.init(M, D, F.G, (int)blockIdx.x);
        KPtr P = kparams(); pg8::EpiRes<true> E{P->in[0], P->in[1], P->out, XB, ssq1};
        pg8::gemm_phase<pg8::EpiRes<true>, pg8::StaticOrder, true, true>(F.lds, g, S, E, F.wave);
    }
    SEAM(3);
    if (IN(4)) {
        pg8::Gemm g{XB, (const bf16*)(ws + WS_WUP), M, FF, D}; pg8::StaticOrder S; S.init(M, FF, F.G, (int)blockIdx.x);
        pg8::EpiUp E{(bf16*)(ws + WS_H), ssq1};
        pg8::gemm_phase<pg8::EpiUp, pg8::StaticOrder, true, true>(F.lds, g, S, E, F.wave);
    }
    SEAM(4);
    if (IN(5)) {
        pg8::Gemm g{(const bf16*)(ws + WS_H), (const bf16*)(ws + WS_WD), M, D, FF}; pg8::StaticOrder S; S.init(M, D, F.G, (int)blockIdx.x);
        pg8::EpiRes<false> E{nullptr, nullptr, kparams()->out, XB, ssq2};
        pg8::gemm_phase<pg8::EpiRes<false>, pg8::StaticOrder, true, true>(F.lds, g, S, E, F.wave);
    }
    SEAM(5);
    if (IN(6)) {
        pg8::Gemm g{XB, (const bf16*)(ws + WS_WG), M, D, D}; pg8::StaticOrder S; S.init(M, D, F.G, (int)blockIdx.x);
        pg8::EpiGate E{kparams()->out, (const bf16*)(ws + WS_PP), ssq2, ssq3};
        pg8::gemm_phase<pg8::EpiGate, pg8::StaticOrder, true, true>(F.lds, g, S, E, F.wave);
    }
    SEAM(6);
    if (IN(7)) { FRAME_LANES(F); p7_final(F, kparams()); }
#undef IN
#undef SEAM
}

extern "C" void kernel_launch(void* const* d_in, const int* in_sizes, int n_in, void* d_out, int out_size, void* d_ws, size_t ws_size, hipStream_t stream) {
    static int grid = 0;
    if (grid == 0) {
        if (n_in != 22 || in_sizes[0] != MP * D || out_size != 34536448 || ws_size < WS_END) { fprintf(stderr, "kernel_launch: unexpected shapes: n_in %d in0 %d out %d ws %zu (need %zu)\n", n_in, n_in > 0 ? in_sizes[0] : -1, out_size, ws_size, (size_t)WS_END); grid = -1; return; }
        int dev = 0, cus = 0, per_cu = 0;
        if (hipGetDevice(&dev) != hipSuccess || hipDeviceGetAttribute(&cus, hipDeviceAttributeMultiprocessorCount, dev) != hipSuccess) { grid = -1; return; }
        if (hipFuncSetAttribute((const void*)trunk_fwd, hipFuncAttributeMaxDynamicSharedMemorySize, LDS_BYTES) != hipSuccess) { fprintf(stderr, "kernel_launch: hipFuncSetAttribute failed\n"); grid = -1; return; }
        if (hipOccupancyMaxActiveBlocksPerMultiprocessor(&per_cu, (const void*)trunk_fwd, NWAVES * 64, LDS_BYTES) != hipSuccess || per_cu < 1) { fprintf(stderr, "kernel_launch: occupancy query says %d blocks per CU\n", per_cu); (void)hipGetLastError(); grid = -1; return; }
        grid = cus;
    }
    if (grid < 0) return;
    (void)hipMemsetAsync((char*)d_ws + WS_CTL, 0, CTL_ZERO_BYTES, stream);
    Params p{};
    for (int i = 0; i < 22; ++i) p.in[i] = (const float*)d_in[i];
    p.out = (float*)d_out; p.ws = (unsigned char*)d_ws;
#if MK_N_LAUNCHES == 1
    p.ph_lo = 0; p.ph_hi = N_PHASES;
    void* args[] = {&p};
    hipError_t e = hipLaunchCooperativeKernel((const void*)trunk_fwd, dim3(grid), dim3(NWAVES * 64), args, LDS_BYTES, stream);
    if (e != hipSuccess) fprintf(stderr, "kernel_launch: cooperative launch failed: %s (grid %d)\n", hipGetErrorString(e), grid);
#else
    for (int li = 0; li < N_PHASES; ++li) { p.ph_lo = li; p.ph_hi = li + 1; hipLaunchKernelGGL(trunk_fwd, dim3(grid), dim3(NWAVES * 64), LDS_BYTES, stream, p); }
#endif
}
```

```cpp
#include <hip/hip_runtime.h>
#include <hip/hip_cooperative_groups.h>
#include <hip/hip_bf16.h>
#include <cstdio>
#include <cstdint>
namespace cg = cooperative_groups;
namespace pg8 {
#define PG8_LAS __attribute__((address_space(3)))
typedef unsigned short bf16_t;
typedef short bf16x8 __attribute__((ext_vector_type(8)));
typedef float f32x4 __attribute__((ext_vector_type(4)));
typedef unsigned u32x4 __attribute__((ext_vector_type(4)));
constexpr int BM = 256, BK = 64, HALF = 128, HTB = HALF * BK * 2  , STAGE_BYTES = 8 * HTB, NXCD = 8, WGM = 8;

__host__ __device__ __forceinline__ int lds_byte(int r, int c) { const int st = (r >> 4) * 2 + (c >> 5), rr = r & 15, cc = c & 31, ob = rr * 64 + cc * 2; return st * 1024 + (ob ^ (((ob >> 9) & 1) << 5)); }
__host__ __device__ __forceinline__ void stage_rc(int b, int& R, int& C) { const int st = b / 1024, sb = b % 1024, swz = sb ^ (((sb >> 9) & 1) << 5); R = (st >> 1) * 16 + swz / 64; C = (st & 1) * 32 + (swz % 64) / 2; }
__host__ __device__ __forceinline__ int perm32(int rho) { const int n = rho >> 4, i = rho & 15; return 8 * (i >> 2) + 4 * n + (i & 3); }

struct Unit { int pm, pn; };
struct Gemm { const bf16_t* A; const bf16_t* Bt; int M, N, K; };

struct StaticOrder {
    int nM, nN, nwg, G, c;
    __host__ __device__ void init(int M, int N, int G_, int c_) { nM = M / BM; nN = N / BM; nwg = nM * nN; G = G_; c = c_; }
    __host__ __device__ bool next(int i, Unit& u) const {
        const long L = (long)i * G + c; if (L >= nwg) return false;
        int wgid = (int)L; { const int q = nwg / NXCD, r = nwg % NXCD, xcd = wgid % NXCD, off = wgid / NXCD; wgid = (xcd < r ? xcd * (q + 1) : r * (q + 1) + (xcd - r) * q) + off; }
        const int nig = WGM * nN, gid = wgid / nig, fm = gid * WGM, gsz = (nM - fm) < WGM ? (nM - fm) : WGM;
        u.pm = fm + ((wgid % nig) % gsz); u.pn = (wgid % nig) / gsz; return true;
    }
    __device__ __forceinline__ void a_ready(const Unit&) const {}
    __device__ __forceinline__ void done(const Unit&) const {}
};

__device__ __forceinline__ unsigned cvt_pk_bf16(float lo, float hi) { unsigned r; asm volatile("v_cvt_pk_bf16_f32 %0, %1, %2" : "=v"(r) : "v"(lo), "v"(hi)); return r; }
typedef float f32x2 __attribute__((ext_vector_type(2)));
__device__ __forceinline__ int lane_id() { int l; asm volatile("v_mbcnt_lo_u32_b32 %0, -1, 0\n\tv_mbcnt_hi_u32_b32 %0, -1, %0" : "=v"(l)); return l; }
template <class Epi, class Sched, bool ALIGN_EPI = false, bool SP2 = false>
__device__ __forceinline__ void gemm_phase(PG8_LAS unsigned char* lds, const Gemm g, const Sched& S, const Epi& E, int wave_in) {
    const int wid = __builtin_amdgcn_readfirstlane(wave_in), lane = lane_id(), tid = wid * 64 + lane, wr = wid >> 2, wc = wid & 3, fr = lane & 15, fq = lane >> 4;
    const int K = g.K, nt = K / BK;
    unsigned voffA[2], voffB[2];
#pragma unroll
    for (int i = 0; i < 2; ++i) { int R, C; stage_rc(tid * 16 + i * 8192, R, C); const int Rb = Epi::PERM ? ((R & ~31) + perm32(R & 31)) : R;
        voffA[i] = (unsigned)(R * K + C) * 2u; voffB[i] = (unsigned)(Rb * K + C) * 2u; }
    const size_t kstep = (size_t)(BK * 2);
    const size_t hstep = (size_t)HALF * K * 2;
    const size_t tstep = 2 * hstep;
    const unsigned ldsw = (unsigned)wid * 1024u;
    const int aoff = lds_byte(wr * 64 + fr, fq * 8), boff = lds_byte(wc * 32 + fr, fq * 8);
#define PG8_SA(b, h) (((b) * 2 + (h)) * HTB)
#define PG8_SB(b, h) ((4 + (b) * 2 + (h)) * HTB)
#define PG8_STAGE(bufoff, gbase, voff) do { _Pragma("unroll") for (int _i = 0; _i < 2; ++_i) \
        __builtin_amdgcn_global_load_lds((const unsigned*)((const char*)(gbase) + (voff)[_i]), (PG8_LAS unsigned*)(lds + (bufoff) + ldsw + _i * 8192), 16, 0, 0); } while (0)
#define PG8_LDA(dst, b, h) do { _Pragma("unroll") for (int m = 0; m < 4; ++m) _Pragma("unroll") for (int k = 0; k < 2; ++k) dst[m][k] = *(const PG8_LAS bf16x8*)(lds + PG8_SA(b, h) + aoff + m * 2048 + k * 1024); } while (0)
#define PG8_LDB(dst, b, h) do { _Pragma("unroll") for (int n = 0; n < 2; ++n) _Pragma("unroll") for (int k = 0; k < 2; ++k) dst[n][k] = *(const PG8_LAS bf16x8*)(lds + PG8_SB(b, h) + boff + n * 2048 + k * 1024); } while (0)
#define PG8_MMA(ai, bj, At, Bt) do { __builtin_amdgcn_s_setprio(1); _Pragma("unroll") for (int m = 0; m < 4; ++m) _Pragma("unroll") for (int n = 0; n < 2; ++n) _Pragma("unroll") for (int k = 0; k < 2; ++k) \
        acc[ai][bj][m][n] = __builtin_amdgcn_mfma_f32_16x16x32_bf16(Bt[n][k], At[m][k], acc[ai][bj][m][n], 0, 0, 0); __builtin_amdgcn_s_setprio(0); } while (0)
#define PG8_WAIT_V(n) asm volatile("s_waitcnt vmcnt(" #n ")" ::: "memory")
#define PG8_WAIT_L(n) asm volatile("s_waitcnt lgkmcnt(" #n ")" ::: "memory")
#define PG8_BAR __builtin_amdgcn_s_barrier()
#define PG8_SCHED __builtin_amdgcn_sched_barrier(0)
    Unit cur, nxt; int ui = 0;
    if (!S.next(0, cur)) return;
    f32x4 acc[2][2][4][2];
#pragma unroll
    for (int a = 0; a < 2; ++a)
#pragma unroll
        for (int b = 0; b < 2; ++b)
#pragma unroll
            for (int m = 0; m < 4; ++m)
#pragma unroll
                for (int n = 0; n < 2; ++n) acc[a][b][m][n] = (f32x4){0.f, 0.f, 0.f, 0.f};
    bf16x8 At[4][2], B0[2][2], B1[2][2];
    const char* cA = (const char*)g.A + (size_t)cur.pm * tstep; const char* cB = (const char*)g.Bt + (size_t)cur.pn * tstep;
    S.a_ready(cur);
    if constexpr (SP2) {
        PG8_STAGE(PG8_SB(0, 0), cB, voffB); PG8_STAGE(PG8_SB(0, 1), cB + hstep, voffB); PG8_STAGE(PG8_SA(0, 0), cA, voffA); PG8_STAGE(PG8_SA(0, 1), cA + hstep, voffA);
        if (wr == 1) PG8_BAR;
        PG8_WAIT_V(2); PG8_BAR;
        PG8_STAGE(PG8_SB(1, 0), cB + kstep, voffB); PG8_STAGE(PG8_SA(1, 0), cA + kstep, voffA); PG8_STAGE(PG8_SB(1, 1), cB + hstep + kstep, voffB);
        PG8_WAIT_V(6); PG8_BAR;
    } else {
        PG8_STAGE(PG8_SB(0, 0), cB, voffB); PG8_STAGE(PG8_SA(0, 0), cA, voffA); PG8_STAGE(PG8_SB(0, 1), cB + hstep, voffB); PG8_STAGE(PG8_SA(0, 1), cA + hstep, voffA);
        if (wr == 1) PG8_BAR;
        PG8_WAIT_V(4); PG8_BAR;
        PG8_STAGE(PG8_SB(1, 0), cB + kstep, voffB); PG8_STAGE(PG8_SA(1, 0), cA + kstep, voffA); PG8_STAGE(PG8_SB(1, 1), cB + hstep + kstep, voffB);
        PG8_WAIT_V(6); PG8_BAR;
    }
    for (;;) {
        const bool has_next = S.next(ui + 1, nxt);
        const char* nA = has_next ? (const char*)g.A + (size_t)nxt.pm * tstep : cA; const char* nB = has_next ? (const char*)g.Bt + (size_t)nxt.pn * tstep : cB;
        for (int t = 0; t < nt; t += 2) {
            const bool last = (t == nt - 2);
            const char* a1 = cA + (size_t)(t + 1) * kstep;
            const char* a2 = last ? nA : cA + (size_t)(t + 2) * kstep; const char* b2 = last ? nB : cB + (size_t)(t + 2) * kstep;
            const char* a3 = a2 + kstep; const char* b3 = b2 + kstep;
            if (last && has_next) S.a_ready(nxt);
            if constexpr (SP2) {
            PG8_LDB(B0, 0, 0); PG8_LDB(B1, 0, 1); PG8_SCHED; PG8_LDA(At, 0, 0); PG8_STAGE(PG8_SA(1, 1), a1 + hstep, voffA);
            PG8_WAIT_V(8); PG8_WAIT_L(0); PG8_BAR; PG8_MMA(0, 0, At, B0); PG8_MMA(0, 1, At, B1); PG8_BAR; PG8_SCHED;
            PG8_LDA(At, 0, 1); PG8_STAGE(PG8_SB(0, 0), b2, voffB); PG8_STAGE(PG8_SB(0, 1), b2 + hstep, voffB); PG8_STAGE(PG8_SA(0, 0), a2, voffA);
            PG8_WAIT_V(8); PG8_WAIT_L(0); PG8_BAR; PG8_MMA(1, 0, At, B0); PG8_MMA(1, 1, At, B1); PG8_BAR; PG8_SCHED;
            PG8_LDB(B0, 1, 0); PG8_LDB(B1, 1, 1); PG8_SCHED; PG8_LDA(At, 1, 0); PG8_STAGE(PG8_SA(0, 1), a2 + hstep, voffA);
            PG8_WAIT_V(8); PG8_WAIT_L(0); PG8_BAR; PG8_MMA(0, 0, At, B0); PG8_MMA(0, 1, At, B1); PG8_BAR; PG8_SCHED;
            PG8_LDA(At, 1, 1); PG8_STAGE(PG8_SB(1, 0), b3, voffB); PG8_STAGE(PG8_SB(1, 1), b3 + hstep, voffB); PG8_STAGE(PG8_SA(1, 0), a3, voffA);
            PG8_WAIT_V(8); PG8_WAIT_L(0); PG8_BAR; PG8_MMA(1, 0, At, B0); PG8_MMA(1, 1, At, B1); PG8_BAR; PG8_SCHED;
            } else {
            PG8_LDB(B0, 0, 0); PG8_SCHED; PG8_LDA(At, 0, 0); PG8_STAGE(PG8_SA(1, 1), a1 + hstep, voffA);
            PG8_WAIT_L(8); PG8_BAR; PG8_WAIT_L(0); PG8_MMA(0, 0, At, B0); PG8_BAR; PG8_SCHED;
            PG8_LDB(B1, 0, 1); PG8_STAGE(PG8_SB(0, 0), b2, voffB);
            PG8_BAR; PG8_WAIT_L(0); PG8_MMA(0, 1, At, B1); PG8_BAR;
            PG8_LDA(At, 0, 1); PG8_STAGE(PG8_SA(0, 0), a2, voffA);
            PG8_BAR; PG8_WAIT_L(0); PG8_MMA(1, 0, At, B0); PG8_BAR; PG8_SCHED;
            PG8_STAGE(PG8_SB(0, 1), b2 + hstep, voffB);
            PG8_WAIT_V(6); PG8_BAR; PG8_MMA(1, 1, At, B1); PG8_BAR;
            PG8_LDB(B0, 1, 0); PG8_SCHED; PG8_LDA(At, 1, 0); PG8_STAGE(PG8_SA(0, 1), a2 + hstep, voffA);
            PG8_WAIT_L(8); PG8_BAR; PG8_WAIT_L(0); PG8_MMA(0, 0, At, B0); PG8_BAR; PG8_SCHED;
            PG8_LDB(B1, 1, 1); PG8_STAGE(PG8_SB(1, 0), b3, voffB);
            PG8_BAR; PG8_WAIT_L(0); PG8_MMA(0, 1, At, B1); PG8_BAR;
            PG8_LDA(At, 1, 1); PG8_STAGE(PG8_SA(1, 0), a3, voffA);
            PG8_BAR; PG8_WAIT_L(0); PG8_MMA(1, 0, At, B0); PG8_BAR; PG8_SCHED;
            PG8_STAGE(PG8_SB(1, 1), b3 + hstep, voffB);
            PG8_WAIT_V(6); PG8_BAR; PG8_MMA(1, 1, At, B1); PG8_BAR;
            }
        }
        if constexpr (ALIGN_EPI) { if (wr == 0) PG8_BAR; }
        if constexpr (!Epi::AFTER_DRAIN) { E(acc, cur, wr, wc, fr, fq); S.done(cur); }
        if (!has_next) break;
#pragma unroll
        for (int a = 0; a < 2; ++a)
#pragma unroll
            for (int b = 0; b < 2; ++b)
#pragma unroll
                for (int m = 0; m < 4; ++m)
#pragma unroll
                    for (int n = 0; n < 2; ++n) acc[a][b][m][n] = (f32x4){0.f, 0.f, 0.f, 0.f};
        cur = nxt; cA = nA; cB = nB; ++ui;
        if constexpr (ALIGN_EPI) { if (wr == 1) PG8_BAR; }
    }
    PG8_WAIT_V(0);
    if constexpr (!ALIGN_EPI) { if (wr == 0) PG8_BAR; }
    PG8_BAR;
    if constexpr (Epi::AFTER_DRAIN) { E.fused(acc, cur, wr, wc, fr, fq, lds, wid, lane); S.done(cur); }
#undef PG8_SA
#undef PG8_SB
#undef PG8_STAGE
#undef PG8_LDA
#undef PG8_LDB
#undef PG8_MMA
#undef PG8_WAIT_V
#undef PG8_WAIT_L
#undef PG8_BAR
#undef PG8_SCHED
}
constexpr int OUT_KP = 34078720, OUT_VP = 34111488, OUT_PP = 34144256, OUT_KS = 34159616, OUT_VS = 34225152, OUT_PS = 34290688;
constexpr float QSCALE = 0.125f * 1.4426950408889634f;
constexpr float RMS_EPS = 1e-6f;

__device__ __forceinline__ u32x4 pack8(f32x4 v0, f32x4 v1) { u32x4 w; w.x = cvt_pk_bf16(v0[0], v0[1]); w.y = cvt_pk_bf16(v0[2], v0[3]); w.z = cvt_pk_bf16(v1[0], v1[1]); w.w = cvt_pk_bf16(v1[2], v1[3]); return w; }
__device__ __forceinline__ float bf_lo(unsigned w) { return __uint_as_float(w << 16); }
__device__ __forceinline__ float bf_hi(unsigned w) { return __uint_as_float(w & 0xffff0000u); }

typedef unsigned u32x2 __attribute__((ext_vector_type(2)));
__device__ __forceinline__ u32x2 pack4(f32x4 v) { u32x2 w; w.x = cvt_pk_bf16(v[0], v[1]); w.y = cvt_pk_bf16(v[2], v[3]); return w; }
struct EpiPlain {
    static constexpr bool PERM = true, AFTER_DRAIN = false, HAS_SSQ = false;
    bf16_t* O; int ldc;
    __device__ __forceinline__ float* ssq_dst() const { return nullptr; }
    __device__ __forceinline__ float quad(int row, int col, f32x4 v) const { *(u32x2*)(O + (size_t)row * ldc + col) = pack4(v); return 0.f; }
    __device__ __forceinline__ void operator()(const f32x4 (&acc)[2][2][4][2], const Unit& u, int wr, int wc, int fr, int fq) const {
        const int row0 = u.pm * BM + wr * 64 + fr, col0 = u.pn * BM + wc * 32 + 8 * fq;
#pragma unroll
        for (int ai = 0; ai < 2; ++ai)
#pragma unroll
            for (int m = 0; m < 4; ++m) { bf16_t* rowp = O + (size_t)(row0 + ai * HALF + m * 16) * ldc + col0;
#pragma unroll
                for (int bj = 0; bj < 2; ++bj) *(u32x4*)(rowp + bj * HALF) = pack8(acc[ai][bj][m][0], acc[ai][bj][m][1]); }
    }
};
struct EpiIn {
    static constexpr bool PERM = true, AFTER_DRAIN = false, HAS_SSQ = false;
    bf16_t* Z; float* out;
    __device__ __forceinline__ float* ssq_dst() const { return nullptr; }
    __device__ __forceinline__ float quad(int row, int col, f32x4 v) const {
        const float sc = (col < 512) ? QSCALE : 1.f;
        *(u32x2*)(Z + (size_t)row * 1280 + col) = pack4(v * sc);
        if (col >= 512) { const int rs = row - 32768, b = rs >> 4, t = rs & 15; long dst = -1;
            if (col < 640) dst = OUT_KS + (long)rs * 128 + (col - 512);
            else if (col < 768) dst = OUT_VS + (long)rs * 128 + (col - 640);
            else if (t >= 1) dst = OUT_PS + (long)(b * 15 + (t - 1)) * 512 + (col - 768);
            if (dst >= 0) *(f32x4*)(out + dst) = v; }
        return 0.f; }
    __device__ __forceinline__ void operator()(const f32x4 (&acc)[2][2][4][2], const Unit& u, int wr, int wc, int fr, int fq) const {
        const int row0 = u.pm * BM + wr * 64 + fr, col0 = u.pn * BM + wc * 32 + 8 * fq;
        const float sc = (u.pn < 2) ? QSCALE : 1.f;
#pragma unroll
        for (int ai = 0; ai < 2; ++ai)
#pragma unroll
            for (int m = 0; m < 4; ++m) { bf16_t* rowp = Z + (size_t)(row0 + ai * HALF + m * 16) * 1280 + col0;
#pragma unroll
                for (int bj = 0; bj < 2; ++bj) *(u32x4*)(rowp + bj * HALF) = pack8(acc[ai][bj][m][0] * sc, acc[ai][bj][m][1] * sc); }
        const bool special = (u.pn >= 2) && (u.pm == 63 || u.pm == 127);
        if (special) {
#pragma unroll
            for (int ai = 0; ai < 2; ++ai)
#pragma unroll
                for (int m = 0; m < 4; ++m) { const int row = row0 + ai * HALF + m * 16;
#pragma unroll
                    for (int bj = 0; bj < 2; ++bj) { const int col = col0 + bj * HALF;
                        long dst = -1;
                        if (row < 32768) { const int b = row >> 14, t = row & 16383;
                            if (col < 640) { if (t >= 16256) dst = OUT_KP + (long)(b * 128 + (t - 16256)) * 128 + (col - 512); }
                            else if (col < 768) { if (t >= 16256) dst = OUT_VP + (long)(b * 128 + (t - 16256)) * 128 + (col - 640); }
                            else { if (t >= 16369) dst = OUT_PP + (long)(b * 15 + (t - 16369)) * 512 + (col - 768); }
                        } else { const int rs = row - 32768, b = rs >> 4, t = rs & 15;
                            if (col < 640) dst = OUT_KS + (long)rs * 128 + (col - 512);
                            else if (col < 768) dst = OUT_VS + (long)rs * 128 + (col - 640);
                            else { if (t >= 1) dst = OUT_PS + (long)(b * 15 + (t - 1)) * 512 + (col - 768); }
                        }
                        if (dst >= 0) { *(f32x4*)(out + dst) = acc[ai][bj][m][0]; *(f32x4*)(out + dst + 4) = acc[ai][bj][m][1]; } } }
        }
    }
};
template <bool FIRST> struct EpiRes {
    static constexpr bool PERM = true, AFTER_DRAIN = false, HAS_SSQ = true;
    const float* xp; const float* xs; float* xo; bf16_t* xb; float* ssq;
    __device__ __forceinline__ float* ssq_dst() const { return ssq; }
    __device__ __forceinline__ float quad(int row, int col, f32x4 acc) const {
        const size_t off = (size_t)row * 1024 + col;
        const float* src = FIRST ? (row < 32768 ? xp + off : xs + (off - (size_t)32768 * 1024)) : xo + off;
        const f32x4 v = *(const f32x4*)src + acc;
        *(f32x4*)(xo + off) = v; *(u32x2*)(xb + off) = pack4(v);
        return (v[0] * v[0] + v[1] * v[1]) + (v[2] * v[2] + v[3] * v[3]); }
    __device__ __forceinline__ void operator()(const f32x4 (&acc)[2][2][4][2], const Unit& u, int wr, int wc, int fr, int fq) const {
        const int row0 = u.pm * BM + wr * 64 + fr, col0 = u.pn * BM + wc * 32 + 8 * fq;
#pragma unroll
        for (int ai = 0; ai < 2; ++ai)
#pragma unroll
            for (int m = 0; m < 4; ++m) { const int row = row0 + ai * HALF + m * 16; const size_t off = (size_t)row * 1024 + col0;
                const float* src = FIRST ? (row < 32768 ? xp + off : xs + (off - (size_t)32768 * 1024)) : xo + off;
                float s = 0.f;
#pragma unroll
                for (int bj = 0; bj < 2; ++bj) { const f32x4 a0 = *(const f32x4*)(src + bj * HALF), a1 = *(const f32x4*)(src + bj * HALF + 4);
                    const f32x4 v0 = a0 + acc[ai][bj][m][0], v1 = a1 + acc[ai][bj][m][1];
                    *(f32x4*)(xo + off + bj * HALF) = v0; *(f32x4*)(xo + off + bj * HALF + 4) = v1;
                    *(u32x4*)(xb + off + bj * HALF) = pack8(v0, v1);
                    s += (v0[0] * v0[0] + v0[1] * v0[1]) + (v0[2] * v0[2] + v0[3] * v0[3]) + (v1[0] * v1[0] + v1[1] * v1[1]) + (v1[2] * v1[2] + v1[3] * v1[3]); }
                s += __shfl_xor(s, 16); s += __shfl_xor(s, 32);
                if (fq == 0) atomicAdd(ssq + row, s); }
    }
};
struct EpiUp {
    static constexpr bool PERM = true, AFTER_DRAIN = false, HAS_SSQ = false;
    bf16_t* H; const float* ssq;
    __device__ __forceinline__ float* ssq_dst() const { return nullptr; }
    __device__ __forceinline__ float quad(int row, int col, f32x4 acc) const {
        const float rs = rsqrtf(ssq[row] * (1.f / 1024.f) + RMS_EPS); f32x4 v = acc * rs;
#pragma unroll
        for (int e = 0; e < 4; ++e) { const float a = fmaxf(v[e], 0.f); v[e] = a * a; }
        *(u32x2*)(H + (size_t)row * 4096 + col) = pack4(v); return 0.f; }
    __device__ __forceinline__ void operator()(const f32x4 (&acc)[2][2][4][2], const Unit& u, int wr, int wc, int fr, int fq) const {
        const int row0 = u.pm * BM + wr * 64 + fr, col0 = u.pn * BM + wc * 32 + 8 * fq;
#pragma unroll
        for (int ai = 0; ai < 2; ++ai)
#pragma unroll
            for (int m = 0; m < 4; ++m) { const int row = row0 + ai * HALF + m * 16; const float rs = rsqrtf(ssq[row] * (1.f / 1024.f) + RMS_EPS);
                bf16_t* rowp = H + (size_t)row * 4096 + col0;
#pragma unroll
                for (int bj = 0; bj < 2; ++bj) { f32x4 v0 = acc[ai][bj][m][0] * rs, v1 = acc[ai][bj][m][1] * rs;
#pragma unroll
                    for (int e = 0; e < 4; ++e) { const float a = fmaxf(v0[e], 0.f), b = fmaxf(v1[e], 0.f); v0[e] = a * a; v1[e] = b * b; }
                    *(u32x4*)(rowp + bj * HALF) = pack8(v0, v1); } }
    }
};
struct EpiGate {
    static constexpr bool PERM = true, AFTER_DRAIN = false, HAS_SSQ = true;
    float* xo; const bf16_t* pp; const float* ssq_in; float* ssq_out;
    __device__ __forceinline__ float* ssq_dst() const { return ssq_out; }
    __device__ __forceinline__ float quad(int row, int col, f32x4 acc) const {
        const size_t off = (size_t)row * 1024 + col;
        const float rs = rsqrtf(ssq_in[row] * (1.f / 1024.f) + RMS_EPS) * (-1.4426950408889634f);
        const f32x4 a0 = *(const f32x4*)(xo + off); const u32x2 pw = *(const u32x2*)(pp + off);
        const f32x4 p0 = (f32x4){bf_lo(pw.x), bf_hi(pw.x), bf_lo(pw.y), bf_hi(pw.y)}; f32x4 v;
#pragma unroll
        for (int e = 0; e < 4; ++e) v[e] = a0[e] + __builtin_amdgcn_rcpf(1.f + __builtin_amdgcn_exp2f(acc[e] * rs)) * p0[e];
        *(f32x4*)(xo + off) = v;
        return (v[0] * v[0] + v[1] * v[1]) + (v[2] * v[2] + v[3] * v[3]); }
    __device__ __forceinline__ void operator()(const f32x4 (&acc)[2][2][4][2], const Unit& u, int wr, int wc, int fr, int fq) const {
        const int row0 = u.pm * BM + wr * 64 + fr, col0 = u.pn * BM + wc * 32 + 8 * fq;
#pragma unroll
        for (int ai = 0; ai < 2; ++ai)
#pragma unroll
            for (int m = 0; m < 4; ++m) { const int row = row0 + ai * HALF + m * 16; const size_t off = (size_t)row * 1024 + col0;
                const float rs = rsqrtf(ssq_in[row] * (1.f / 1024.f) + RMS_EPS) * (-1.4426950408889634f);
                float s = 0.f;
#pragma unroll
                for (int bj = 0; bj < 2; ++bj) { const f32x4 a0 = *(const f32x4*)(xo + off + bj * HALF), a1 = *(const f32x4*)(xo + off + bj * HALF + 4);
                    const u32x4 pw = *(const u32x4*)(pp + off + bj * HALF);
                    const f32x4 p0 = (f32x4){bf_lo(pw.x), bf_hi(pw.x), bf_lo(pw.y), bf_hi(pw.y)}, p1 = (f32x4){bf_lo(pw.z), bf_hi(pw.z), bf_lo(pw.w), bf_hi(pw.w)};
                    f32x4 v0, v1;
#pragma unroll
                    for (int e = 0; e < 4; ++e) { const float g0 = __builtin_amdgcn_rcpf(1.f + __builtin_amdgcn_exp2f(acc[ai][bj][m][0][e] * rs)), g1 = __builtin_amdgcn_rcpf(1.f + __builtin_amdgcn_exp2f(acc[ai][bj][m][1][e] * rs));
                        v0[e] = a0[e] + g0 * p0[e]; v1[e] = a1[e] + g1 * p1[e]; }
                    *(f32x4*)(xo + off + bj * HALF) = v0; *(f32x4*)(xo + off + bj * HALF + 4) = v1;
                    s += (v0[0] * v0[0] + v0[1] * v0[1]) + (v0[2] * v0[2] + v0[3] * v0[3]) + (v1[0] * v1[0] + v1[1] * v1[1]) + (v1[2] * v1[2] + v1[3] * v1[3]); }
                s += __shfl_xor(s, 16); s += __shfl_xor(s, 32);
                if (fq == 0) atomicAdd(ssq_out + row, s); }
    }
};
}
constexpr int NWAVES = 8;
constexpr int MP = 32768, MS = 512, M = MP + MS;
constexpr int D = 1024, NIN = 1280, FF = 4096, PLE = 256, SEQ = 16384;
#ifndef MK_N_LAUNCHES
#define MK_N_LAUNCHES 1
#endif
constexpr int N_PHASES = 8;
constexpr size_t MiB = 1u << 20;
constexpr size_t WS_CTL = 0, CTL_ZERO_BYTES = 1 * MiB;
constexpr size_t WS_SSQ1 = 0, WS_SSQ2 = 160 * 1024, WS_SSQ3 = 320 * 1024, WS_BAR = 512 * 1024;
constexpr size_t WS_WIN = 1 * MiB;
constexpr size_t WS_WO = 4 * MiB;
constexpr size_t WS_WUP = 6 * MiB;
constexpr size_t WS_WD = 14 * MiB;
constexpr size_t WS_WG = 22 * MiB;
constexpr size_t WS_WPLE = 24 * MiB;
constexpr size_t WS_WPOOL = 24 * MiB + 512 * 1024;
constexpr size_t WS_PLEB = 26 * MiB;
constexpr size_t WS_PP = 43 * MiB;
constexpr size_t WS_XB = 108 * MiB;
constexpr size_t WS_H = 173 * MiB;
constexpr size_t WS_Z = 173 * MiB;
constexpr size_t WS_MIX = 255 * MiB;
constexpr size_t WS_END = 433 * MiB;
static_assert(WS_Z + (size_t)M * NIN * 2 <= WS_MIX && WS_MIX + (size_t)M * D * 2 <= WS_END && WS_H + (size_t)M * FF * 2 <= WS_END && WS_XB + (size_t)M * D * 2 <= WS_H && WS_PP + (size_t)M * D * 2 <= WS_XB && WS_PLEB + (size_t)M * PLE * 2 <= WS_PP, "d_ws map");
constexpr int LDS_BYTES = 147456;
constexpr int MISC_OFF = 140 * 1024;
#define GAS __attribute__((address_space(1)))
#define LAS __attribute__((address_space(3)))
typedef unsigned short bf16;
typedef unsigned v4u __attribute__((ext_vector_type(4)));
typedef unsigned v2u __attribute__((ext_vector_type(2)));
typedef float f32x4 __attribute__((ext_vector_type(4)));
typedef float f32x16 __attribute__((ext_vector_type(16)));
typedef short bf16x8 __attribute__((ext_vector_type(8)));
typedef short s16x4 __attribute__((ext_vector_type(4)));
#define LDS_WAIT() asm volatile("s_waitcnt lgkmcnt(0)" ::: "memory")
__device__ __forceinline__ unsigned f2bf(float f) { unsigned u = __builtin_bit_cast(unsigned, f); return (u + 0x7fffu + ((u >> 16) & 1u)) >> 16; }
__device__ __forceinline__ unsigned pk2(float lo, float hi) { return f2bf(lo) | (f2bf(hi) << 16); }
__device__ __forceinline__ float bflo(unsigned w) { return __uint_as_float(w << 16); }
__device__ __forceinline__ float bfhi(unsigned w) { return __uint_as_float(w & 0xffff0000u); }
__device__ __forceinline__ float wave_sum(float v) {
#pragma unroll
    for (int o = 1; o < 64; o <<= 1) v += __shfl_xor(v, o);
    return v;
}

#define RLX_AGENT __ATOMIC_RELAXED, __HIP_MEMORY_SCOPE_AGENT
#define XB_TMO      128
#define XB_XCNT(j)  (256  + 64 * (j))
#define XB_XSUB(j)  (1280 + 64 * (j))
#define XB_XGEN(j)  (2304 + 64 * (j))
#define XB_TOP      3328
#define XB_TOPGEN   3392
#define XCD_BAR_WORDS 3456
#define XB_SPIN_CAP (1u << 18)

__device__ __forceinline__ unsigned xb_ld(unsigned* p)              { return __hip_atomic_load(p, __ATOMIC_RELAXED, __HIP_MEMORY_SCOPE_AGENT); }
__device__ __forceinline__ unsigned xb_add(unsigned* p, unsigned v) { return __hip_atomic_fetch_add(p, v, __ATOMIC_RELAXED, __HIP_MEMORY_SCOPE_AGENT); }
__device__ __forceinline__ unsigned xb_xcc_id() { return (unsigned)__builtin_amdgcn_s_getreg((3 << 11) | 20) & 0xFu; }
#define XB_SPIN(cond, bar) do { unsigned _sp = 0; while (cond) { __builtin_amdgcn_s_sleep(1); \
    if ((++_sp & 255u) == 0u) { if (xb_ld(&(bar)[XB_TMO])) break; if (_sp > XB_SPIN_CAP) { atomicAdd(&(bar)[XB_TMO], 1u); break; } } } } while (0)

struct XcdBarrier {
    unsigned* bar; unsigned x;
    volatile LAS unsigned* st;
};

__device__ __forceinline__ XcdBarrier xcd_barrier_post(unsigned* bar, volatile LAS unsigned* st, bool leader) {
    XcdBarrier b; b.bar = bar; b.x = xb_xcc_id(); b.st = st;
    if (leader) (void)xb_add(&bar[XB_XCNT(b.x)], 1u);
    return b;
}
__device__ __forceinline__ void xcd_barrier_complete(unsigned* bar, unsigned x, unsigned& nloc, unsigned& nx) {
    const unsigned G = gridDim.x * gridDim.y * gridDim.z;
    unsigned sum, cnt, mine, sp = 0u;
    for (;;) {
        sum = 0u; cnt = 0u; mine = 0u;
#pragma unroll
        for (unsigned j = 0; j < 16; ++j) { const unsigned c = xb_ld(&bar[XB_XCNT(j)]); sum += c; cnt += (c > 0u) ? 1u : 0u; mine = (j == x) ? c : mine; }
        if (sum == G) break;
        __builtin_amdgcn_s_sleep(1);
        if ((++sp & 255u) == 0u) { if (xb_ld(&bar[XB_TMO])) break; if (sp > XB_SPIN_CAP) { atomicAdd(&bar[XB_TMO], 1u); break; } }
    }
    nloc = mine > 0u ? mine : 1u; nx = cnt > 0u ? cnt : 1u;
}

__device__ __forceinline__ void xcd_barrier(const XcdBarrier& b, bool leader) {
    asm volatile("s_waitcnt vmcnt(0)" ::: "memory");
    __syncthreads();
    if (leader) {
        unsigned* bar = b.bar;
        __builtin_amdgcn_s_waitcnt(0);
        unsigned nloc = b.st[0], nx = b.st[1];
        if (nloc == 0u) { xcd_barrier_complete(bar, b.x, nloc, nx); b.st[0] = nloc; b.st[1] = nx; }
        const unsigned old = xb_add(&bar[XB_XSUB(b.x)], 1u);
        const unsigned gen = old / nloc;
        if (old + 1u == (gen + 1u) * nloc) {
            __builtin_amdgcn_fence(__ATOMIC_RELEASE, "agent");
            asm volatile("s_waitcnt vmcnt(0)" ::: "memory");
            const unsigned og = xb_add(&bar[XB_TOP], 1u);
            const unsigned tg = og / nx;
            if (og + 1u == (tg + 1u) * nx) xb_add(&bar[XB_TOPGEN], 1u);
            else XB_SPIN(xb_ld(&bar[XB_TOPGEN]) == tg, bar);
            __builtin_amdgcn_fence(__ATOMIC_ACQUIRE, "agent");
            xb_add(&bar[XB_XGEN(b.x)], 1u);
            asm volatile("s_waitcnt vmcnt(0)" ::: "memory");
        } else {
            XB_SPIN(xb_ld(&bar[XB_XGEN(b.x)]) == gen, bar);
            __builtin_amdgcn_fence(__ATOMIC_ACQUIRE, "agent");
            asm volatile("s_waitcnt vmcnt(0)" ::: "memory");
        }
    }
    __syncthreads();
}

struct Params { const float* in[22]; float* out; unsigned char* ws; int ph_lo, ph_hi; };
struct Frame { LAS unsigned char* lds; int tid, lane, wave, vcu, G; };
#define FRAME_LANES(F) do { (F).lane = pg8::lane_id(); (F).tid = (F).wave * 64 + (F).lane; } while (0)
typedef const __attribute__((address_space(4))) Params* KPtr;
__device__ __forceinline__ KPtr kparams() { KPtr k = (KPtr)__builtin_amdgcn_kernarg_segment_ptr(); asm volatile("" : "+s"(k)); return k; }

__device__ __forceinline__ void p0_transpose_item(const float* W, const float* g, int K, int N, bf16* WT, LAS float* scr, int item, int lane) {
    const int nblk = N / 32, kb = item / nblk, nb = item % nblk, k0 = 64 * kb, n0 = 32 * nb;
#pragma unroll 8
    for (int i = 0; i < 32; ++i) { const int kk = 2 * i + (lane >> 5); const float gv = g ? g[k0 + kk] : 1.f; scr[kk * 33 + (lane & 31)] = W[(size_t)(k0 + kk) * N + n0 + (lane & 31)] * gv; }
    LDS_WAIT(); asm volatile("" ::: "memory");
    const int c = lane & 7;
#pragma unroll
    for (int j = 0; j < 4; ++j) { const int n = (lane >> 3) + 8 * j; const LAS float* s = scr + (8 * c) * 33 + n;
        v4u o; o.x = pk2(s[0 * 33], s[1 * 33]); o.y = pk2(s[2 * 33], s[3 * 33]); o.z = pk2(s[4 * 33], s[5 * 33]); o.w = pk2(s[6 * 33], s[7 * 33]);
        *(GAS v4u*)(WT + (size_t)(n0 + n) * K + k0 + 8 * c) = o; }
    LDS_WAIT(); asm volatile("" ::: "memory");
}
__device__ __forceinline__ void p0_prologue(const Frame& F, KPtr P) {
    LAS float* scr = (LAS float*)(F.lds + F.wave * 16384);
    const int gw = F.vcu * NWAVES + F.wave, NGW = F.G * NWAVES;
    unsigned char* ws = P->ws;
    constexpr int I_IN = 16 * 40, I_O = 16 * 32, I_UP = 16 * 128, I_D = 64 * 32, I_G = 16 * 32, I_PLE = 4 * 32, I_POOL = 4 * 8;
    constexpr int NITEMS = I_IN + I_O + I_UP + I_D + I_G + I_PLE + I_POOL;
    for (int it = gw; it < NITEMS; it += NGW) {
        int r = it;
        if (r < I_UP) { p0_transpose_item(P->in[16], P->in[15], D, FF, (bf16*)(ws + WS_WUP), scr, r, F.lane); continue; } r -= I_UP;
        if (r < I_D) { p0_transpose_item(P->in[17], nullptr, FF, D, (bf16*)(ws + WS_WD), scr, r, F.lane); continue; } r -= I_D;
        if (r < I_IN) { p0_transpose_item(P->in[8], nullptr, D, NIN, (bf16*)(ws + WS_WIN), scr, r, F.lane); continue; } r -= I_IN;
        if (r < I_O) { p0_transpose_item(P->in[14], nullptr, D, D, (bf16*)(ws + WS_WO), scr, r, F.lane); continue; } r -= I_O;
        if (r < I_G) { p0_transpose_item(P->in[19], P->in[18], D, D, (bf16*)(ws + WS_WG), scr, r, F.lane); continue; } r -= I_G;
        if (r < I_PLE) { p0_transpose_item(P->in[20], nullptr, PLE, D, (bf16*)(ws + WS_WPLE), scr, r, F.lane); continue; } r -= I_PLE;
        { const int g = r >> 3; p0_transpose_item(P->in[11] + g * 16384, nullptr, 128, 128, (bf16*)(ws + WS_WPOOL) + g * 16384, scr, r & 7, F.lane); }
    }
    const float* lnm = P->in[7];
    f32x4 gv[4];
#pragma unroll
    for (int j = 0; j < 4; ++j) gv[j] = ((const f32x4*)lnm)[F.lane + 64 * j];
    bf16* XN = (bf16*)(ws + WS_XB);
    for (int m = gw; m < M; m += NGW) {
        const float* xrow = (m < MP) ? P->in[0] + (size_t)m * D : P->in[1] + (size_t)(m - MP) * D;
        const GAS f32x4* xr = (const GAS f32x4*)xrow + F.lane;
        f32x4 v[4]; float s = 0.f;
#pragma unroll
        for (int j = 0; j < 4; ++j) { v[j] = xr[64 * j]; s += (v[j].x * v[j].x + v[j].y * v[j].y) + (v[j].z * v[j].z + v[j].w * v[j].w); }
        const float rstd = rsqrtf(wave_sum(s) * (1.f / D) + pg8::RMS_EPS);
        GAS v2u* o8 = (GAS v2u*)(XN + (size_t)m * D) + F.lane;
#pragma unroll
        for (int j = 0; j < 4; ++j) { v2u o; o.x = pk2(v[j].x * rstd * gv[j].x, v[j].y * rstd * gv[j].y); o.y = pk2(v[j].z * rstd * gv[j].z, v[j].w * rstd * gv[j].w); o8[64 * j] = o; }
    }
    bf16* PB = (bf16*)(ws + WS_PLEB);
    for (int m = gw; m < M; m += NGW) {
        const float* prow = (m < MP) ? P->in[5] + (size_t)m * PLE : P->in[6] + (size_t)(m - MP) * PLE;
        const f32x4 v = ((const GAS f32x4*)prow)[F.lane];
        v2u o; o.x = pk2(v.x, v.y); o.y = pk2(v.z, v.w);
        ((GAS v2u*)(PB + (size_t)m * PLE))[F.lane] = o;
    }
}

constexpr int KSB = 272;
constexpr int L_K = 0, L_V = 192 * KSB, L_U = 0, USB = 1040  , L_SCR = 120 * 1024;
static_assert(2 * 192 * KSB <= L_SCR && 79 * USB <= L_SCR, "P2 LDS map");
__device__ __forceinline__ int crow(int r, int hi) { return (r & 3) + 8 * (r >> 2) + 4 * hi; }
__device__ __forceinline__ bf16x8 pack_step(const f32x16& x, int s) {
    v4u p; p.x = pg8::cvt_pk_bf16(x[8 * s], x[8 * s + 1]); p.y = pg8::cvt_pk_bf16(x[8 * s + 2], x[8 * s + 3]); p.z = pg8::cvt_pk_bf16(x[8 * s + 4], x[8 * s + 5]); p.w = pg8::cvt_pk_bf16(x[8 * s + 6], x[8 * s + 7]);
    return __builtin_bit_cast(bf16x8, p);
}
typedef short v4i16_t __attribute__((ext_vector_type(4)));
__device__ __forceinline__ s16x4 vtr(const LAS unsigned char* p) { return __builtin_bit_cast(s16x4, __builtin_amdgcn_ds_read_tr16_b64_v4i16((LAS v4i16_t*)p)); }

__device__ __forceinline__ void mix_unit(const Frame& F, KPtr P, int unit) {
    unsigned char* ws = P->ws;
    const bf16* Z = (const bf16*)(ws + WS_Z);
    bf16* MIX = (bf16*)(ws + WS_MIX);
    const int tid = F.tid, lane = F.lane, wave = F.wave, r32 = lane & 31, hi = lane >> 5;
    LAS unsigned char* lds = F.lds;
    const bool prompt = unit < 512;
    int qrow0, nq, kmin, kmax, pos0, sb = 0;
    if (prompt) { const int b = unit >> 8, c = unit & 255; qrow0 = b * SEQ + c * 64; nq = 64; kmin = (c >= 2) ? 0 : (2 - c) * 64; kmax = 192; pos0 = c * 64; }
    else { sb = unit - 512; qrow0 = MP + sb * 16; nq = 16; kmin = 0; kmax = 144; pos0 = 2048; }
    const int nqt = (nq + 31) >> 5;
    for (int p = tid; p < 192 * 32; p += NWAVES * 64) {
        const int row = p >> 5, cp = p & 31;
        v4u val = (v4u){0u, 0u, 0u, 0u};
        if (row >= kmin && row < kmax) {
            if (prompt) val = *(const GAS v4u*)(Z + (size_t)(qrow0 - 128 + row) * NIN + 512 + cp * 8);
            else if (row >= 128) val = *(const GAS v4u*)(Z + (size_t)(qrow0 + row - 128) * NIN + 512 + cp * 8);
            else { const float* src = ((cp < 16) ? P->in[2] : P->in[3]) + (size_t)(sb * 128 + row) * 128 + (cp & 15) * 8;
                const f32x4 a = *(const GAS f32x4*)src, b2 = *(const GAS f32x4*)(src + 4);
                val.x = pk2(a.x, a.y); val.y = pk2(a.z, a.w); val.z = pk2(b2.x, b2.y); val.w = pk2(b2.z, b2.w); }
        }
        *(LAS v4u*)(lds + ((cp < 16) ? L_K : L_V) + row * KSB + (cp & 15) * 16) = val;
    }
    __syncthreads();
    const int hd = wave, kvh = wave >> 2;
    const float sink2 = P->in[9][hd] * 1.4426950408889634f;
    LAS float* scr = (LAS float*)(lds + L_SCR);
    float biasv[6][2];
#pragma unroll
    for (int j = 0; j < 6; ++j)
#pragma unroll
        for (int rh = 0; rh < 2; ++rh) { const int k0 = 32 * j + 16 * rh; biasv[j][rh] = (k0 >= kmin && k0 < kmax) ? 0.f : -INFINITY; }
    const float* ga = P->in[10];
#ifndef NO_ATT
#pragma unroll 1
    for (int qt = 0; qt < nqt; ++qt) {
        f32x16 o[2];
#pragma unroll
        for (int db = 0; db < 2; ++db)
#pragma unroll
            for (int r = 0; r < 16; ++r) o[db][r] = 0.f;
        const int ql = 32 * qt + r32; const int qrow = qrow0 + (ql < nq ? ql : 0);
        bf16x8 qr[4];
#pragma unroll
        for (int ds = 0; ds < 4; ++ds) qr[ds] = *(const GAS bf16x8*)(Z + (size_t)qrow * NIN + hd * 64 + ds * 16 + hi * 8);
        float mx = sink2;
#pragma unroll
        for (int j = 0; j < 6; ++j) {
            f32x16 T;
#pragma unroll
            for (int r = 0; r < 16; ++r) T[r] = biasv[j][r >> 3];
#pragma unroll
            for (int ds = 0; ds < 4; ++ds) { const bf16x8 kf = *(const LAS bf16x8*)(lds + L_K + (32 * j + r32) * KSB + (kvh * 64 + ds * 16 + hi * 8) * 2);
                T = __builtin_amdgcn_mfma_f32_32x32x16_bf16(kf, qr[ds], T, 0, 0, 0); }
#pragma unroll
            for (int r = 0; r < 16; ++r) mx = fmaxf(mx, T[r]);
        }
        mx = fmaxf(mx, __shfl_xor(mx, 32));
        float ls = 0.f;
        const int i16 = lane & 15, qd = i16 >> 2, pp4 = i16 & 3, blk = (lane >> 4) & 1;
        const LAS unsigned char* vbase = lds + L_V + (4 * hi + qd) * KSB + (kvh * 64 + 16 * blk + 4 * pp4) * 2;
#pragma unroll
        for (int j = 0; j < 6; ++j) {
            f32x16 T;
#pragma unroll
            for (int r = 0; r < 16; ++r) T[r] = biasv[j][r >> 3] - mx;
#pragma unroll
            for (int ds = 0; ds < 4; ++ds) { const bf16x8 kf = *(const LAS bf16x8*)(lds + L_K + (32 * j + r32) * KSB + (kvh * 64 + ds * 16 + hi * 8) * 2);
                T = __builtin_amdgcn_mfma_f32_32x32x16_bf16(kf, qr[ds], T, 0, 0, 0); }
#pragma unroll
            for (int r = 0; r < 16; ++r) { T[r] = __builtin_amdgcn_exp2f(T[r]); ls += T[r]; }
#pragma unroll
            for (int s = 0; s < 2; ++s) { const bf16x8 pf = pack_step(T, s);
#pragma unroll
                for (int db = 0; db < 2; ++db) { const LAS unsigned char* vp = vbase + (32 * j + 16 * s) * KSB + 64 * db;
                    const s16x4 lo = vtr(vp), hi4 = vtr(vp + 8 * KSB);
                    const bf16x8 vf = __builtin_shufflevector(lo, hi4, 0, 1, 2, 3, 4, 5, 6, 7);
                    o[db] = __builtin_amdgcn_mfma_f32_32x32x16_bf16(vf, pf, o[db], 0, 0, 0); } }
        }
        ls += __shfl_xor(ls, 32);
        const float inv = 1.f / (ls + __builtin_amdgcn_exp2f(sink2 - mx));
        float sq = 0.f;
#pragma unroll
        for (int db = 0; db < 2; ++db)
#pragma unroll
            for (int r = 0; r < 16; ++r) { o[db][r] *= inv; sq += o[db][r] * o[db][r]; }
        sq += __shfl_xor(sq, 32);
        if (hi == 0) scr[wave * 32 + r32] = sq;
        __syncthreads();
        float tot = 0.f;
#pragma unroll
        for (int w = 0; w < 8; ++w) tot += scr[w * 32 + r32];
        const float rstd = rsqrtf(tot * (1.f / 512.f) + pg8::RMS_EPS);
        if (ql < nq) { bf16* orow = MIX + (size_t)(qrow0 + ql) * D + hd * 64;
#pragma unroll
            for (int db = 0; db < 2; ++db)
#pragma unroll
                for (int rg = 0; rg < 4; ++rg) { const int d0 = 32 * db + 8 * rg + 4 * hi; const f32x4 g = *(const f32x4*)(ga + hd * 64 + d0);
                    v2u w; w.x = pk2(o[db][4 * rg] * rstd * g.x, o[db][4 * rg + 1] * rstd * g.y); w.y = pk2(o[db][4 * rg + 2] * rstd * g.z, o[db][4 * rg + 3] * rstd * g.w);
                    *(GAS v2u*)(orow + d0) = w; } }
        __syncthreads();
    }
#endif
#ifndef NO_POOL
    for (int p = tid; p < 79 * 64; p += NWAVES * 64) {
        const int i = p >> 6, cp = p & 63;
        v4u val = (v4u){0u, 0u, 0u, 0u};
        if (i < 15 + nq) {
            if (i >= 15) val = *(const GAS v4u*)(Z + (size_t)(qrow0 + i - 15) * NIN + 768 + cp * 8);
            else if (prompt) { if (pos0 > 0) val = *(const GAS v4u*)(Z + (size_t)(qrow0 + i - 15) * NIN + 768 + cp * 8); }
            else { const float* src = P->in[4] + (size_t)(sb * 15 + i) * 512 + cp * 8; const f32x4 a = *(const GAS f32x4*)src, b2 = *(const GAS f32x4*)(src + 4);
                val.x = pk2(a.x, a.y); val.y = pk2(a.z, a.w); val.z = pk2(b2.x, b2.y); val.w = pk2(b2.z, b2.w); }
        }
        *(LAS v4u*)(lds + L_U + i * USB + cp * 16) = val;
    }
    __syncthreads();
    {
        const int g = wave >> 1, eh = wave & 1, w = 2 << g;
        const bf16* WpT = (const bf16*)(ws + WS_WPOOL) + g * 16384;
        const float* psc = P->in[12]; const float* gp = P->in[13];
        f32x16 bacc[2][2];
        float ssqb[2];
#pragma unroll
        for (int tt = 0; tt < 2; ++tt) {
            ssqb[tt] = 0.f;
#pragma unroll
            for (int et = 0; et < 2; ++et)
#pragma unroll
                for (int r = 0; r < 16; ++r) bacc[tt][et][r] = 0.f;
            if (tt < nqt) {
                const int t = 32 * tt + r32;
                const int pc = pos0 + t + 1; const float icnt = 1.f / (float)(pc < w ? pc : w);
#pragma unroll 2
                for (int ks = 0; ks < 8; ++ks) {
                    const int c = g * 128 + 16 * ks + 8 * hi;
                    const LAS unsigned char* up = lds + L_U + (15 + t) * USB + c * 2;
                    float sum[8];
#pragma unroll
                    for (int e = 0; e < 8; ++e) sum[e] = 0.f;
                    for (int i = 0; i < w; ++i) { const v4u x = *(const LAS v4u*)(up - i * USB);
                        sum[0] += bflo(x.x); sum[1] += bfhi(x.x); sum[2] += bflo(x.y); sum[3] += bfhi(x.y); sum[4] += bflo(x.z); sum[5] += bfhi(x.z); sum[6] += bflo(x.w); sum[7] += bfhi(x.w); }
                    const v4u x0 = *(const LAS v4u*)up;
                    v4u dv; dv.x = pk2(sum[0] * icnt - bflo(x0.x), sum[1] * icnt - bfhi(x0.x)); dv.y = pk2(sum[2] * icnt - bflo(x0.y), sum[3] * icnt - bfhi(x0.y));
                    dv.z = pk2(sum[4] * icnt - bflo(x0.z), sum[5] * icnt - bfhi(x0.z)); dv.w = pk2(sum[6] * icnt - bflo(x0.w), sum[7] * icnt - bfhi(x0.w));
                    const bf16x8 df = __builtin_bit_cast(bf16x8, dv);
#pragma unroll
                    for (int et = 0; et < 2; ++et) { const bf16x8 wf = *(const GAS bf16x8*)(WpT + (size_t)(64 * eh + 32 * et + r32) * 128 + 16 * ks + 8 * hi);
                        bacc[tt][et] = __builtin_amdgcn_mfma_f32_32x32x16_bf16(wf, df, bacc[tt][et], 0, 0, 0); }
                }
                float sq = 0.f;
#pragma unroll
                for (int et = 0; et < 2; ++et)
#pragma unroll
                    for (int rg = 0; rg < 4; ++rg) { const f32x4 sc = *(const f32x4*)(psc + g * 128 + 64 * eh + 32 * et + 8 * rg + 4 * hi);
#pragma unroll
                        for (int e = 0; e < 4; ++e) { const float v = bacc[tt][et][4 * rg + e] * sc[e]; bacc[tt][et][4 * rg + e] = v; sq += v * v; } }
                sq += __shfl_xor(sq, 32);
                ssqb[tt] = sq;
            }
        }
        if (hi == 0) { scr[512 + (0 * 8 + wave) * 32 + r32] = ssqb[0]; scr[512 + (1 * 8 + wave) * 32 + r32] = ssqb[1]; }
        __syncthreads();
#pragma unroll
        for (int tt = 0; tt < 2; ++tt) if (tt < nqt) {
            float tot = 0.f;
#pragma unroll
            for (int w2 = 0; w2 < 8; ++w2) tot += scr[512 + (tt * 8 + w2) * 32 + r32];
            const float rstd = rsqrtf(tot * (1.f / 512.f) + pg8::RMS_EPS);
            const int t = 32 * tt + r32;
            if (t < nq) { bf16* orow = MIX + (size_t)(qrow0 + t) * D + 512 + g * 128 + 64 * eh;
#pragma unroll
                for (int et = 0; et < 2; ++et)
#pragma unroll
                    for (int rg = 0; rg < 4; ++rg) { const int e0 = 32 * et + 8 * rg + 4 * hi; const f32x4 gg = *(const f32x4*)(gp + g * 128 + 64 * eh + e0);
                        v2u wv; wv.x = pk2(bacc[tt][et][4 * rg] * rstd * gg.x, bacc[tt][et][4 * rg + 1] * rstd * gg.y); wv.y = pk2(bacc[tt][et][4 * rg + 2] * rstd * gg.z, bacc[tt][et][4 * rg + 3] * rstd * gg.w);
                        *(GAS v2u*)(orow + e0) = wv; } }
        }
    }
    __syncthreads();
#endif
}


typedef float f32x4t __attribute__((ext_vector_type(4)));
template <class Epi>
__device__ __forceinline__ void tail_gemm(const Frame& F, const bf16* A, const bf16* Bt, int N, int K, const Epi& E) {
    const int lane = F.lane, wave = F.wave, tid = F.tid, c16 = lane & 15, g4 = lane >> 4;
    LAS float* red = (LAS float*)F.lds;
    const int ntiles = 32 * (N >> 7), kw = K >> 3;
    for (int tile = F.vcu; tile < ntiles; tile += F.G) {
        const int mt = tile & 31, nt = tile >> 5;
        f32x4t acc[8];
#pragma unroll
        for (int j = 0; j < 8; ++j) acc[j] = (f32x4t){0.f, 0.f, 0.f, 0.f};
        const bf16* ap = A + (size_t)(mt * 16 + c16) * K + wave * kw + 8 * g4;
        const bf16* bp = Bt + (size_t)(nt * 128 + c16) * K + wave * kw + 8 * g4;
        for (int k = 0; k < kw; k += 32) {
            const bf16x8 a = *(const GAS bf16x8*)(ap + k);
#pragma unroll
            for (int j = 0; j < 8; ++j) { const bf16x8 b = *(const GAS bf16x8*)(bp + (size_t)(16 * j) * K + k);
                acc[j] = __builtin_amdgcn_mfma_f32_16x16x32_bf16(b, a, acc[j], 0, 0, 0); }
        }
#pragma unroll
        for (int j = 0; j < 8; ++j) *(LAS f32x4t*)(red + (wave * 16 + c16) * 132 + 16 * j + 4 * g4) = acc[j];
        __syncthreads();
        const int row = tid >> 5, cg4 = (tid & 31) * 4;
        f32x4t v = (f32x4t){0.f, 0.f, 0.f, 0.f};
#pragma unroll
        for (int w = 0; w < 8; ++w) v += *(const LAS f32x4t*)(red + (w * 16 + row) * 132 + cg4);
        float sq = E.quad(MP + mt * 16 + row, nt * 128 + cg4, v);
        if (Epi::HAS_SSQ) {
#pragma unroll
            for (int o = 1; o < 32; o <<= 1) sq += __shfl_xor(sq, o);
            if ((lane & 31) == 0) atomicAdd(E.ssq_dst() + MP + mt * 16 + row, sq);
        }
        __syncthreads();
    }
}

__device__ __forceinline__ void p7_final(const Frame& F, KPtr P) {
    const int gw = F.vcu * NWAVES + F.wave, NGW = F.G * NWAVES;
    const float* ssq3 = (const float*)(P->ws + WS_SSQ3); const float* gf = P->in[21];
    f32x4 gv[4];
#pragma unroll
    for (int j = 0; j < 4; ++j) gv[j] = ((const f32x4*)gf)[F.lane + 64 * j];
    for (int m = gw; m < M; m += NGW) {
        GAS f32x4* xr = (GAS f32x4*)(P->out + (size_t)m * D) + F.lane;
        const float rstd = rsqrtf(ssq3[m] * (1.f / D) + pg8::RMS_EPS);
#pragma unroll
        for (int j = 0; j < 4; ++j) { f32x4 v = xr[64 * j]; v = v * rstd * gv[j]; xr[64 * j] = v; }
    }
}

__global__ void __launch_bounds__(NWAVES * 64, 2) trunk_fwd(Params Pv) {
    extern __shared__ __attribute__((aligned(16))) unsigned char lds[];
    Frame F;
    F.lds = (LAS unsigned char*)lds;
    { int t_ = (int)threadIdx.x; asm volatile("" : "+v"(t_)); F.wave = __builtin_amdgcn_readfirstlane(t_ >> 6); } F.tid = 0; F.lane = 0;
    F.G = gridDim.x; { const int bx = blockIdx.x; F.vcu = (F.G % 8 == 0) ? (bx % 8) * (F.G / 8) + bx / 8 : bx; }
    unsigned char* ws = kparams()->ws;
    const int lo = kparams()->ph_lo, hi = kparams()->ph_hi;
#ifndef PHASE_MASK
#define PHASE_MASK 255
#endif
#define IN(k) (((PHASE_MASK >> (k)) & 1) && lo <= (k) && (k) < hi)
    volatile LAS unsigned* MISC = (volatile LAS unsigned*)(F.lds + MISC_OFF);
    if (pg8::lane_id() < 2 && F.wave == 0) MISC[pg8::lane_id()] = 0u;
    __syncthreads();
    XcdBarrier bar; bar.bar = (unsigned*)(ws + WS_BAR); bar.x = 0; bar.st = MISC;
    if (hi - lo > 2) bar = xcd_barrier_post((unsigned*)(ws + WS_BAR), MISC, F.wave == 0 && pg8::lane_id() == 0);
#define SEAM(k) do { if (IN(k) && IN((k) + 1)) { if ((k) == 0) cg::this_grid().sync(); else xcd_barrier(bar, F.wave == 0 && pg8::lane_id() == 0); } } while (0)
    float* ssq1 = (float*)(ws + WS_SSQ1); float* ssq2 = (float*)(ws + WS_SSQ2); float* ssq3 = (float*)(ws + WS_SSQ3);
    bf16* XB = (bf16*)(ws + WS_XB);

    if (IN(0)) { FRAME_LANES(F); p0_prologue(F, kparams()); }
    SEAM(0);
    if (IN(1)) {
        { pg8::Gemm g{XB, (const bf16*)(ws + WS_WIN), MP, NIN, D}; pg8::StaticOrder S; S.init(MP, NIN, F.G, (int)blockIdx.x);
          pg8::EpiIn E{(bf16*)(ws + WS_Z), kparams()->out};
          pg8::gemm_phase<pg8::EpiIn, pg8::StaticOrder, true, true>(F.lds, g, S, E, F.wave); }
        { pg8::Gemm g{(const bf16*)(ws + WS_PLEB), (const bf16*)(ws + WS_WPLE), MP, D, PLE}; pg8::StaticOrder S;
          if (F.G == 256) S.init(MP, D, 128, (int)blockIdx.x >= 128 ? (int)blockIdx.x - 128 : (1 << 24)); else S.init(MP, D, F.G, (int)blockIdx.x);
          pg8::EpiPlain E{(bf16*)(ws + WS_PP), D};
          pg8::gemm_phase<pg8::EpiPlain, pg8::StaticOrder, true, true>(F.lds, g, S, E, F.wave); }
        FRAME_LANES(F);
        { pg8::EpiIn E{(bf16*)(ws + WS_Z), kparams()->out}; tail_gemm(F, XB + (size_t)MP * D, (const bf16*)(ws + WS_WIN), NIN, D, E); }
        { pg8::EpiPlain E{(bf16*)(ws + WS_PP), D}; tail_gemm(F, (const bf16*)(ws + WS_PLEB) + (size_t)MP * PLE, (const bf16*)(ws + WS_WPLE), D, PLE, E); }
    }
    SEAM(1);
    if (IN(2)) {
        FRAME_LANES(F); for (int u = F.vcu; u < 544; u += F.G) mix_unit(F, kparams(), u);
    }
    SEAM(2);
    if (IN(3)) {
        pg8::Gemm g{(const bf16*)(ws + WS_MIX), (const bf16*)(ws + WS_WO), MP, D, D}; pg8::StaticOrder S; S.init(MP, D, F.G, (int)blockIdx.x);
        KPtr P = kparams(); pg8::EpiRes<true> E{P->in[0], P->in[1], P->out, XB, ssq1};
        pg8::gemm_phase<pg8::EpiRes<true>, pg8::StaticOrder, true, true>(F.lds, g, S, E, F.wave);
        FRAME_LANES(F); tail_gemm(F, (const bf16*)(ws + WS_MIX) + (size_t)MP * D, (const bf16*)(ws + WS_WO), D, D, E);
    }
    SEAM(3);
    if (IN(4)) {
        pg8::Gemm g{XB, (const bf16*)(ws + WS_WUP), MP, FF, D}; pg8::StaticOrder S; S.init(MP, FF, F.G, (int)blockIdx.x);
        pg8::EpiUp E{(bf16*)(ws + WS_H), ssq1};
        pg8::gemm_phase<pg8::EpiUp, pg8::StaticOrder, true, true>(F.lds, g, S, E, F.wave);
        FRAME_LANES(F); tail_gemm(F, XB + (size_t)MP * D, (const bf16*)(ws + WS_WUP), FF, D, E);
    }
    SEAM(4);
    if (IN(5)) {
        pg8::Gemm g{(const bf16*)(ws + WS_H), (const bf16*)(ws + WS_WD), MP, D, FF}; pg8::StaticOrder S; S.init(MP, D, F.G, (int)blockIdx.x);
        pg8::EpiRes<false> E{nullptr, nullptr, kparams()->out, XB, ssq2};
        pg8::gemm_phase<pg8::EpiRes<false>, pg8::StaticOrder, true, true>(F.lds, g, S, E, F.wave);
        FRAME_LANES(F); tail_gemm(F, (const bf16*)(ws + WS_H) + (size_t)MP * FF, (const bf16*)(ws + WS_WD), D, FF, E);
    }
    SEAM(5);
    if (IN(6)) {
        pg8::Gemm g{XB, (const bf16*)(ws + WS_WG), MP, D, D}; pg8::StaticOrder S; S.init(MP, D, F.G, (int)blockIdx.x);
        pg8::EpiGate E{kparams()->out, (const bf16*)(ws + WS_PP), ssq2, ssq3};
        pg8::gemm_phase<pg8::EpiGate, pg8::StaticOrder, true, true>(F.lds, g, S, E, F.wave);
        FRAME_LANES(F); tail_gemm(F, XB + (size_t)MP * D, (const bf16*)(ws + WS_WG), D, D, E);
    }
    SEAM(6);
    if (IN(7)) { FRAME_LANES(F); p7_final(F, kparams()); }
#undef IN
#undef SEAM
}

extern "C" void kernel_launch(void* const* d_in, const int* in_sizes, int n_in, void* d_out, int out_size, void* d_ws, size_t ws_size, hipStream_t stream) {
    static int grid = 0;
    if (grid == 0) {
        if (n_in != 22 || in_sizes[0] != MP * D || out_size != 34536448 || ws_size < WS_END) { fprintf(stderr, "kernel_launch: unexpected shapes: n_in %d in0 %d out %d ws %zu (need %zu)\n", n_in, n_in > 0 ? in_sizes[0] : -1, out_size, ws_size, (size_t)WS_END); grid = -1; return; }
        int dev = 0, cus = 0, per_cu = 0;
        if (hipGetDevice(&dev) != hipSuccess || hipDeviceGetAttribute(&cus, hipDeviceAttributeMultiprocessorCount, dev) != hipSuccess) { grid = -1; return; }
        if (hipFuncSetAttribute((const void*)trunk_fwd, hipFuncAttributeMaxDynamicSharedMemorySize, LDS_BYTES) != hipSuccess) { fprintf(stderr, "kernel_launch: hipFuncSetAttribute failed\n"); grid = -1; return; }
        if (hipOccupancyMaxActiveBlocksPerMultiprocessor(&per_cu, (const void*)trunk_fwd, NWAVES * 64, LDS_BYTES) != hipSuccess || per_cu < 1) { fprintf(stderr, "kernel_launch: occupancy query says %d blocks per CU\n", per_cu); (void)hipGetLastError(); grid = -1; return; }
        grid = cus;
    }
    if (grid < 0) return;
    (void)hipMemsetAsync((char*)d_ws + WS_CTL, 0, CTL_ZERO_BYTES, stream);
    Params p{};
    for (int i = 0; i < 22; ++i) p.in[i] = (const float*)d_in[i];
    p.out = (float*)d_out; p.ws = (unsigned char*)d_ws;
#if MK_N_LAUNCHES == 1
    p.ph_lo = 0; p.ph_hi = N_PHASES;
    void* args[] = {&p};
    hipError_t e = hipLaunchCooperativeKernel((const void*)trunk_fwd, dim3(grid), dim3(NWAVES * 64), args, LDS_BYTES, stream);
    if (e != hipSuccess) fprintf(stderr, "kernel_launch: cooperative launch failed: %s (grid %d)\n", hipGetErrorString(e), grid);
#else
    for (int li = 0; li < N_PHASES; ++li) { p.ph_lo = li; p.ph_hi = li + 1; hipLaunchKernelGGL(trunk_fwd, dim3(grid), dim3(NWAVES * 64), LDS_BYTES, stream, p); }
#endif
}
```

```cpp
#include <hip/hip_runtime.h>
#include <hip/hip_cooperative_groups.h>
#include <hip/hip_bf16.h>
#include <cstdio>
#include <cstdint>
namespace cg = cooperative_groups;
namespace pg8 {
#define PG8_LAS __attribute__((address_space(3)))
typedef unsigned short bf16_t;
typedef short bf16x8 __attribute__((ext_vector_type(8)));
typedef float f32x4 __attribute__((ext_vector_type(4)));
typedef unsigned u32x4 __attribute__((ext_vector_type(4)));
constexpr int BM = 256, BK = 64, HALF = 128, HTB = HALF * BK * 2  , STAGE_BYTES = 8 * HTB, NXCD = 8, WGM = 8;

__host__ __device__ __forceinline__ int lds_byte(int r, int c) { const int st = (r >> 4) * 2 + (c >> 5), rr = r & 15, cc = c & 31, ob = rr * 64 + cc * 2; return st * 1024 + (ob ^ (((ob >> 9) & 1) << 5)); }
__host__ __device__ __forceinline__ void stage_rc(int b, int& R, int& C) { const int st = b / 1024, sb = b % 1024, swz = sb ^ (((sb >> 9) & 1) << 5); R = (st >> 1) * 16 + swz / 64; C = (st & 1) * 32 + (swz % 64) / 2; }
__host__ __device__ __forceinline__ int perm32(int rho) { const int n = rho >> 4, i = rho & 15; return 8 * (i >> 2) + 4 * n + (i & 3); }

struct Unit { int pm, pn; };
struct Gemm { const bf16_t* A; const bf16_t* Bt; int M, N, K; };

struct StaticOrder {
    int nM, nN, nwg, G, c;
    __host__ __device__ void init(int M, int N, int G_, int c_) { nM = M / BM; nN = N / BM; nwg = nM * nN; G = G_; c = c_; }
    __host__ __device__ bool next(int i, Unit& u) const {
        const long L = (long)i * G + c; if (L >= nwg) return false;
        int wgid = (int)L; { const int q = nwg / NXCD, r = nwg % NXCD, xcd = wgid % NXCD, off = wgid / NXCD; wgid = (xcd < r ? xcd * (q + 1) : r * (q + 1) + (xcd - r) * q) + off; }
        const int nig = WGM * nN, gid = wgid / nig, fm = gid * WGM, gsz = (nM - fm) < WGM ? (nM - fm) : WGM;
        u.pm = fm + ((wgid % nig) % gsz); u.pn = (wgid % nig) / gsz; return true;
    }
    __device__ __forceinline__ void a_ready(const Unit&) const {}
    __device__ __forceinline__ void done(const Unit&) const {}
};

__device__ __forceinline__ unsigned cvt_pk_bf16(float lo, float hi) { unsigned r; asm volatile("v_cvt_pk_bf16_f32 %0, %1, %2" : "=v"(r) : "v"(lo), "v"(hi)); return r; }
typedef float f32x2 __attribute__((ext_vector_type(2)));
__device__ __forceinline__ int lane_id() { int l; asm volatile("v_mbcnt_lo_u32_b32 %0, -1, 0\n\tv_mbcnt_hi_u32_b32 %0, -1, %0" : "=v"(l)); return l; }
template <class Epi, class Sched, bool ALIGN_EPI = false, bool SP2 = false>
__device__ __forceinline__ void gemm_phase(PG8_LAS unsigned char* lds, const Gemm g, const Sched& S, const Epi& E, int wave_in) {
    const int wid = __builtin_amdgcn_readfirstlane(wave_in), lane = lane_id(), tid = wid * 64 + lane, wr = wid >> 2, wc = wid & 3, fr = lane & 15, fq = lane >> 4;
    const int K = g.K, nt = K / BK;
    unsigned voffA[2], voffB[2];
#pragma unroll
    for (int i = 0; i < 2; ++i) { int R, C; stage_rc(tid * 16 + i * 8192, R, C); const int Rb = Epi::PERM ? ((R & ~31) + perm32(R & 31)) : R;
        voffA[i] = (unsigned)(R * K + C) * 2u; voffB[i] = (unsigned)(Rb * K + C) * 2u; }
    const size_t kstep = (size_t)(BK * 2);
    const size_t hstep = (size_t)HALF * K * 2;
    const size_t tstep = 2 * hstep;
    const unsigned ldsw = (unsigned)wid * 1024u;
    const int aoff = lds_byte(wr * 64 + fr, fq * 8), boff = lds_byte(wc * 32 + fr, fq * 8);
#define PG8_SA(b, h) (((b) * 2 + (h)) * HTB)
#define PG8_SB(b, h) ((4 + (b) * 2 + (h)) * HTB)
#define PG8_STAGE(bufoff, gbase, voff) do { _Pragma("unroll") for (int _i = 0; _i < 2; ++_i) \
        __builtin_amdgcn_global_load_lds((const unsigned*)((const char*)(gbase) + (voff)[_i]), (PG8_LAS unsigned*)(lds + (bufoff) + ldsw + _i * 8192), 16, 0, 0); } while (0)
#define PG8_LDA(dst, b, h) do { _Pragma("unroll") for (int m = 0; m < 4; ++m) _Pragma("unroll") for (int k = 0; k < 2; ++k) dst[m][k] = *(const PG8_LAS bf16x8*)(lds + PG8_SA(b, h) + aoff + m * 2048 + k * 1024); } while (0)
#define PG8_LDB(dst, b, h) do { _Pragma("unroll") for (int n = 0; n < 2; ++n) _Pragma("unroll") for (int k = 0; k < 2; ++k) dst[n][k] = *(const PG8_LAS bf16x8*)(lds + PG8_SB(b, h) + boff + n * 2048 + k * 1024); } while (0)
#define PG8_MMA(ai, bj, At, Bt) do { __builtin_amdgcn_s_setprio(1); _Pragma("unroll") for (int m = 0; m < 4; ++m) _Pragma("unroll") for (int n = 0; n < 2; ++n) _Pragma("unroll") for (int k = 0; k < 2; ++k) \
        acc[ai][bj][m][n] = __builtin_amdgcn_mfma_f32_16x16x32_bf16(Bt[n][k], At[m][k], acc[ai][bj][m][n], 0, 0, 0); __builtin_amdgcn_s_setprio(0); } while (0)
#define PG8_WAIT_V(n) asm volatile("s_waitcnt vmcnt(" #n ")" ::: "memory")
#define PG8_WAIT_L(n) asm volatile("s_waitcnt lgkmcnt(" #n ")" ::: "memory")
#define PG8_BAR __builtin_amdgcn_s_barrier()
#define PG8_SCHED __builtin_amdgcn_sched_barrier(0)
    Unit cur, nxt; int ui = 0;
    if (!S.next(0, cur)) return;
    f32x4 acc[2][2][4][2];
#pragma unroll
    for (int a = 0; a < 2; ++a)
#pragma unroll
        for (int b = 0; b < 2; ++b)
#pragma unroll
            for (int m = 0; m < 4; ++m)
#pragma unroll
                for (int n = 0; n < 2; ++n) acc[a][b][m][n] = (f32x4){0.f, 0.f, 0.f, 0.f};
    bf16x8 At[4][2], B0[2][2], B1[2][2];
    const char* cA = (const char*)g.A + (size_t)cur.pm * tstep; const char* cB = (const char*)g.Bt + (size_t)cur.pn * tstep;
    S.a_ready(cur);
    if constexpr (SP2) {
        PG8_STAGE(PG8_SB(0, 0), cB, voffB); PG8_STAGE(PG8_SB(0, 1), cB + hstep, voffB); PG8_STAGE(PG8_SA(0, 0), cA, voffA); PG8_STAGE(PG8_SA(0, 1), cA + hstep, voffA);
        if (wr == 1) PG8_BAR;
        PG8_WAIT_V(2); PG8_BAR;
        PG8_STAGE(PG8_SB(1, 0), cB + kstep, voffB); PG8_STAGE(PG8_SA(1, 0), cA + kstep, voffA); PG8_STAGE(PG8_SB(1, 1), cB + hstep + kstep, voffB);
        PG8_WAIT_V(6); PG8_BAR;
    } else {
        PG8_STAGE(PG8_SB(0, 0), cB, voffB); PG8_STAGE(PG8_SA(0, 0), cA, voffA); PG8_STAGE(PG8_SB(0, 1), cB + hstep, voffB); PG8_STAGE(PG8_SA(0, 1), cA + hstep, voffA);
        if (wr == 1) PG8_BAR;
        PG8_WAIT_V(4); PG8_BAR;
        PG8_STAGE(PG8_SB(1, 0), cB + kstep, voffB); PG8_STAGE(PG8_SA(1, 0), cA + kstep, voffA); PG8_STAGE(PG8_SB(1, 1), cB + hstep + kstep, voffB);
        PG8_WAIT_V(6); PG8_BAR;
    }
    for (;;) {
        const bool has_next = S.next(ui + 1, nxt);
        const char* nA = has_next ? (const char*)g.A + (size_t)nxt.pm * tstep : cA; const char* nB = has_next ? (const char*)g.Bt + (size_t)nxt.pn * tstep : cB;
        for (int t = 0; t < nt; t += 2) {
            const bool last = (t == nt - 2);
            const char* a1 = cA + (size_t)(t + 1) * kstep;
            const char* a2 = last ? nA : cA + (size_t)(t + 2) * kstep; const char* b2 = last ? nB : cB + (size_t)(t + 2) * kstep;
            const char* a3 = a2 + kstep; const char* b3 = b2 + kstep;
            if (last && has_next) S.a_ready(nxt);
            if constexpr (SP2) {
            PG8_LDB(B0, 0, 0); PG8_LDB(B1, 0, 1); PG8_SCHED; PG8_LDA(At, 0, 0); PG8_STAGE(PG8_SA(1, 1), a1 + hstep, voffA);
            PG8_WAIT_V(8); PG8_WAIT_L(0); PG8_BAR; PG8_MMA(0, 0, At, B0); PG8_MMA(0, 1, At, B1); PG8_BAR; PG8_SCHED;
            PG8_LDA(At, 0, 1); PG8_STAGE(PG8_SB(0, 0), b2, voffB); PG8_STAGE(PG8_SB(0, 1), b2 + hstep, voffB); PG8_STAGE(PG8_SA(0, 0), a2, voffA);
            PG8_WAIT_V(8); PG8_WAIT_L(0); PG8_BAR; PG8_MMA(1, 0, At, B0); PG8_MMA(1, 1, At, B1); PG8_BAR; PG8_SCHED;
            PG8_LDB(B0, 1, 0); PG8_LDB(B1, 1, 1); PG8_SCHED; PG8_LDA(At, 1, 0); PG8_STAGE(PG8_SA(0, 1), a2 + hstep, voffA);
            PG8_WAIT_V(8); PG8_WAIT_L(0); PG8_BAR; PG8_MMA(0, 0, At, B0); PG8_MMA(0, 1, At, B1); PG8_BAR; PG8_SCHED;
            PG8_LDA(At, 1, 1); PG8_STAGE(PG8_SB(1, 0), b3, voffB); PG8_STAGE(PG8_SB(1, 1), b3 + hstep, voffB); PG8_STAGE(PG8_SA(1, 0), a3, voffA);
            PG8_WAIT_V(8); PG8_WAIT_L(0); PG8_BAR; PG8_MMA(1, 0, At, B0); PG8_MMA(1, 1, At, B1); PG8_BAR; PG8_SCHED;
            } else {
            PG8_LDB(B0, 0, 0); PG8_SCHED; PG8_LDA(At, 0, 0); PG8_STAGE(PG8_SA(1, 1), a1 + hstep, voffA);
            PG8_WAIT_L(8); PG8_BAR; PG8_WAIT_L(0); PG8_MMA(0, 0, At, B0); PG8_BAR; PG8_SCHED;
            PG8_LDB(B1, 0, 1); PG8_STAGE(PG8_SB(0, 0), b2, voffB);
            PG8_BAR; PG8_WAIT_L(0); PG8_MMA(0, 1, At, B1); PG8_BAR;
            PG8_LDA(At, 0, 1); PG8_STAGE(PG8_SA(0, 0), a2, voffA);
            PG8_BAR; PG8_WAIT_L(0); PG8_MMA(1, 0, At, B0); PG8_BAR; PG8_SCHED;
            PG8_STAGE(PG8_SB(0, 1), b2 + hstep, voffB);
            PG8_WAIT_V(6); PG8_BAR; PG8_MMA(1, 1, At, B1); PG8_BAR;
            PG8_LDB(B0, 1, 0); PG8_SCHED; PG8_LDA(At, 1, 0); PG8_STAGE(PG8_SA(0, 1), a2 + hstep, voffA);
            PG8_WAIT_L(8); PG8_BAR; PG8_WAIT_L(0); PG8_MMA(0, 0, At, B0); PG8_BAR; PG8_SCHED;
            PG8_LDB(B1, 1, 1); PG8_STAGE(PG8_SB(1, 0), b3, voffB);
            PG8_BAR; PG8_WAIT_L(0); PG8_MMA(0, 1, At, B1); PG8_BAR;
            PG8_LDA(At, 1, 1); PG8_STAGE(PG8_SA(1, 0), a3, voffA);
            PG8_BAR; PG8_WAIT_L(0); PG8_MMA(1, 0, At, B0); PG8_BAR; PG8_SCHED;
            PG8_STAGE(PG8_SB(1, 1), b3 + hstep, voffB);
            PG8_WAIT_V(6); PG8_BAR; PG8_MMA(1, 1, At, B1); PG8_BAR;
            }
        }
        if constexpr (ALIGN_EPI) { if (wr == 0) PG8_BAR; }
        if constexpr (!Epi::AFTER_DRAIN) { E(acc, cur, wr, wc, fr, fq); S.done(cur); }
        if (!has_next) break;
#pragma unroll
        for (int a = 0; a < 2; ++a)
#pragma unroll
            for (int b = 0; b < 2; ++b)
#pragma unroll
                for (int m = 0; m < 4; ++m)
#pragma unroll
                    for (int n = 0; n < 2; ++n) acc[a][b][m][n] = (f32x4){0.f, 0.f, 0.f, 0.f};
        cur = nxt; cA = nA; cB = nB; ++ui;
        if constexpr (ALIGN_EPI) { if (wr == 1) PG8_BAR; }
    }
    PG8_WAIT_V(0);
    if constexpr (!ALIGN_EPI) { if (wr == 0) PG8_BAR; }
    PG8_BAR;
    if constexpr (Epi::AFTER_DRAIN) { E.fused(acc, cur, wr, wc, fr, fq, lds, wid, lane); S.done(cur); }
#undef PG8_SA
#undef PG8_SB
#undef PG8_STAGE
#undef PG8_LDA
#undef PG8_LDB
#undef PG8_MMA
#undef PG8_WAIT_V
#undef PG8_WAIT_L
#undef PG8_BAR
#undef PG8_SCHED
}
constexpr int OUT_KP = 34078720, OUT_VP = 34111488, OUT_PP = 34144256, OUT_KS = 34159616, OUT_VS = 34225152, OUT_PS = 34290688;
constexpr float QSCALE = 0.125f * 1.4426950408889634f;
constexpr float RMS_EPS = 1e-6f;

__device__ __forceinline__ u32x4 pack8(f32x4 v0, f32x4 v1) { u32x4 w; w.x = cvt_pk_bf16(v0[0], v0[1]); w.y = cvt_pk_bf16(v0[2], v0[3]); w.z = cvt_pk_bf16(v1[0], v1[1]); w.w = cvt_pk_bf16(v1[2], v1[3]); return w; }
__device__ __forceinline__ float bf_lo(unsigned w) { return __uint_as_float(w << 16); }
__device__ __forceinline__ float bf_hi(unsigned w) { return __uint_as_float(w & 0xffff0000u); }

typedef unsigned u32x2 __attribute__((ext_vector_type(2)));
__device__ __forceinline__ u32x2 pack4(f32x4 v) { u32x2 w; w.x = cvt_pk_bf16(v[0], v[1]); w.y = cvt_pk_bf16(v[2], v[3]); return w; }
struct EpiPlain {
    static constexpr bool PERM = true, AFTER_DRAIN = false, HAS_SSQ = false;
    bf16_t* O; int ldc;
    __device__ __forceinline__ float* ssq_dst() const { return nullptr; }
    __device__ __forceinline__ float quad(int row, int col, f32x4 v) const { *(u32x2*)(O + (size_t)row * ldc + col) = pack4(v); return 0.f; }
    __device__ __forceinline__ void operator()(const f32x4 (&acc)[2][2][4][2], const Unit& u, int wr, int wc, int fr, int fq) const {
        const int row0 = u.pm * BM + wr * 64 + fr, col0 = u.pn * BM + wc * 32 + 8 * fq;
#pragma unroll
        for (int ai = 0; ai < 2; ++ai)
#pragma unroll
            for (int m = 0; m < 4; ++m) { bf16_t* rowp = O + (size_t)(row0 + ai * HALF + m * 16) * ldc + col0;
#pragma unroll
                for (int bj = 0; bj < 2; ++bj) *(u32x4*)(rowp + bj * HALF) = pack8(acc[ai][bj][m][0], acc[ai][bj][m][1]); }
    }
};
struct EpiIn {
    static constexpr bool PERM = true, AFTER_DRAIN = false, HAS_SSQ = false;
    bf16_t* Z; float* out;
    __device__ __forceinline__ float* ssq_dst() const { return nullptr; }
    __device__ __forceinline__ float quad(int row, int col, f32x4 v) const {
        const float sc = (col < 512) ? QSCALE : 1.f;
        *(u32x2*)(Z + (size_t)row * 1280 + col) = pack4(v * sc);
        if (col >= 512) { const int rs = row - 32768, b = rs >> 4, t = rs & 15; long dst = -1;
            if (col < 640) dst = OUT_KS + (long)rs * 128 + (col - 512);
            else if (col < 768) dst = OUT_VS + (long)rs * 128 + (col - 640);
            else if (t >= 1) dst = OUT_PS + (long)(b * 15 + (t - 1)) * 512 + (col - 768);
            if (dst >= 0) *(f32x4*)(out + dst) = v; }
        return 0.f; }
    __device__ __forceinline__ void operator()(const f32x4 (&acc)[2][2][4][2], const Unit& u, int wr, int wc, int fr, int fq) const {
        const int row0 = u.pm * BM + wr * 64 + fr, col0 = u.pn * BM + wc * 32 + 8 * fq;
        const float sc = (u.pn < 2) ? QSCALE : 1.f;
#pragma unroll
        for (int ai = 0; ai < 2; ++ai)
#pragma unroll
            for (int m = 0; m < 4; ++m) { bf16_t* rowp = Z + (size_t)(row0 + ai * HALF + m * 16) * 1280 + col0;
#pragma unroll
                for (int bj = 0; bj < 2; ++bj) *(u32x4*)(rowp + bj * HALF) = pack8(acc[ai][bj][m][0] * sc, acc[ai][bj][m][1] * sc); }
        const bool special = (u.pn >= 2) && (u.pm == 63 || u.pm == 127);
        if (special) {
#pragma unroll
            for (int ai = 0; ai < 2; ++ai)
#pragma unroll
                for (int m = 0; m < 4; ++m) { const int row = row0 + ai * HALF + m * 16;
#pragma unroll
                    for (int bj = 0; bj < 2; ++bj) { const int col = col0 + bj * HALF;
                        long dst = -1;
                        if (row < 32768) { const int b = row >> 14, t = row & 16383;
                            if (col < 640) { if (t >= 16256) dst = OUT_KP + (long)(b * 128 + (t - 16256)) * 128 + (col - 512); }
                            else if (col < 768) { if (t >= 16256) dst = OUT_VP + (long)(b * 128 + (t - 16256)) * 128 + (col - 640); }
                            else { if (t >= 16369) dst = OUT_PP + (long)(b * 15 + (t - 16369)) * 512 + (col - 768); }
                        } else { const int rs = row - 32768, b = rs >> 4, t = rs & 15;
                            if (col < 640) dst = OUT_KS + (long)rs * 128 + (col - 512);
                            else if (col < 768) dst = OUT_VS + (long)rs * 128 + (col - 640);
                            else { if (t >= 1) dst = OUT_PS + (long)(b * 15 + (t - 1)) * 512 + (col - 768); }
                        }
                        if (dst >= 0) { *(f32x4*)(out + dst) = acc[ai][bj][m][0]; *(f32x4*)(out + dst + 4) = acc[ai][bj][m][1]; } } }
        }
    }
};
__device__ __forceinline__ float sq8(f32x4 v0, f32x4 v1) { return (v0[0] * v0[0] + v0[1] * v0[1]) + (v0[2] * v0[2] + v0[3] * v0[3]) + (v1[0] * v1[0] + v1[1] * v1[1]) + (v1[2] * v1[2] + v1[3] * v1[3]); }
__device__ __forceinline__ void unpack8(u32x4 w, f32x4& v0, f32x4& v1) { v0 = (f32x4){bf_lo(w.x), bf_hi(w.x), bf_lo(w.y), bf_hi(w.y)}; v1 = (f32x4){bf_lo(w.z), bf_hi(w.z), bf_lo(w.w), bf_hi(w.w)}; }
struct EpiRes1 {
    static constexpr bool PERM = true, AFTER_DRAIN = false, HAS_SSQ = true;
    const float* xp; const float* xs; bf16_t* xb; float* ssq;
    __device__ __forceinline__ float* ssq_dst() const { return ssq; }
    __device__ __forceinline__ float quad(int row, int col, f32x4 acc) const {
        const size_t off = (size_t)row * 1024 + col;
        const float* src = (row < 32768 ? xp + off : xs + (off - (size_t)32768 * 1024));
        const f32x4 v = *(const f32x4*)src + acc;
        *(u32x2*)(xb + off) = pack4(v);
        return (v[0] * v[0] + v[1] * v[1]) + (v[2] * v[2] + v[3] * v[3]); }
    __device__ __forceinline__ void operator()(const f32x4 (&acc)[2][2][4][2], const Unit& u, int wr, int wc, int fr, int fq) const {
        const int row0 = u.pm * BM + wr * 64 + fr, col0 = u.pn * BM + wc * 32 + 8 * fq;
#pragma unroll
        for (int ai = 0; ai < 2; ++ai) {
            f32x4 r[4][2][2];
#pragma unroll
            for (int m = 0; m < 4; ++m) { const float* src = xp + (size_t)(row0 + ai * HALF + m * 16) * 1024 + col0;
#pragma unroll
                for (int bj = 0; bj < 2; ++bj) { r[m][bj][0] = *(const f32x4*)(src + bj * HALF); r[m][bj][1] = *(const f32x4*)(src + bj * HALF + 4); } }
            float s4[4];
#pragma unroll
            for (int m = 0; m < 4; ++m) { const size_t off = (size_t)(row0 + ai * HALF + m * 16) * 1024 + col0; float s = 0.f;
#pragma unroll
                for (int bj = 0; bj < 2; ++bj) { const f32x4 v0 = r[m][bj][0] + acc[ai][bj][m][0], v1 = r[m][bj][1] + acc[ai][bj][m][1];
                    *(u32x4*)(xb + off + bj * HALF) = pack8(v0, v1); s += sq8(v0, v1); }
                s += __shfl_xor(s, 16); s += __shfl_xor(s, 32); s4[m] = s; }
            if (fq == 0) {
#pragma unroll
                for (int m = 0; m < 4; ++m) atomicAdd(ssq + row0 + ai * HALF + m * 16, s4[m]); }
        }
    }
};
struct EpiRes2 {
    static constexpr bool PERM = true, AFTER_DRAIN = false, HAS_SSQ = true;
    bf16_t* xb; float* ssq;
    __device__ __forceinline__ float* ssq_dst() const { return ssq; }
    __device__ __forceinline__ float quad(int row, int col, f32x4 acc) const {
        const size_t off = (size_t)row * 1024 + col; const u32x2 w = *(const u32x2*)(xb + off);
        const f32x4 v = (f32x4){bf_lo(w.x), bf_hi(w.x), bf_lo(w.y), bf_hi(w.y)} + acc;
        *(u32x2*)(xb + off) = pack4(v);
        return (v[0] * v[0] + v[1] * v[1]) + (v[2] * v[2] + v[3] * v[3]); }
    __device__ __forceinline__ void operator()(const f32x4 (&acc)[2][2][4][2], const Unit& u, int wr, int wc, int fr, int fq) const {
        const int row0 = u.pm * BM + wr * 64 + fr, col0 = u.pn * BM + wc * 32 + 8 * fq;
        u32x4 r[2][4][2];
#pragma unroll
        for (int ai = 0; ai < 2; ++ai)
#pragma unroll
            for (int m = 0; m < 4; ++m)
#pragma unroll
                for (int bj = 0; bj < 2; ++bj) r[ai][m][bj] = *(const u32x4*)(xb + (size_t)(row0 + ai * HALF + m * 16) * 1024 + col0 + bj * HALF);
        float s8[8];
#pragma unroll
        for (int ai = 0; ai < 2; ++ai)
#pragma unroll
            for (int m = 0; m < 4; ++m) { const size_t off = (size_t)(row0 + ai * HALF + m * 16) * 1024 + col0; float s = 0.f;
#pragma unroll
                for (int bj = 0; bj < 2; ++bj) { f32x4 v0, v1; unpack8(r[ai][m][bj], v0, v1); v0 += acc[ai][bj][m][0]; v1 += acc[ai][bj][m][1];
                    *(u32x4*)(xb + off + bj * HALF) = pack8(v0, v1); s += sq8(v0, v1); }
                s += __shfl_xor(s, 16); s += __shfl_xor(s, 32); s8[ai * 4 + m] = s; }
        if (fq == 0) {
#pragma unroll
            for (int i = 0; i < 8; ++i) atomicAdd(ssq + row0 + (i >> 2) * HALF + (i & 3) * 16, s8[i]); }
    }
};
struct EpiUp {
    static constexpr bool PERM = true, AFTER_DRAIN = false, HAS_SSQ = false;
    bf16_t* H; const float* ssq;
    __device__ __forceinline__ float* ssq_dst() const { return nullptr; }
    __device__ __forceinline__ float quad(int row, int col, f32x4 acc) const {
        const float rs = rsqrtf(ssq[row] * (1.f / 1024.f) + RMS_EPS); f32x4 v = acc * rs;
#pragma unroll
        for (int e = 0; e < 4; ++e) { const float a = fmaxf(v[e], 0.f); v[e] = a * a; }
        *(u32x2*)(H + (size_t)row * 4096 + col) = pack4(v); return 0.f; }
    __device__ __forceinline__ void operator()(const f32x4 (&acc)[2][2][4][2], const Unit& u, int wr, int wc, int fr, int fq) const {
        const int row0 = u.pm * BM + wr * 64 + fr, col0 = u.pn * BM + wc * 32 + 8 * fq;
#pragma unroll
        for (int ai = 0; ai < 2; ++ai)
#pragma unroll
            for (int m = 0; m < 4; ++m) { const int row = row0 + ai * HALF + m * 16; const float rs = rsqrtf(ssq[row] * (1.f / 1024.f) + RMS_EPS);
                bf16_t* rowp = H + (size_t)row * 4096 + col0;
#pragma unroll
                for (int bj = 0; bj < 2; ++bj) { f32x4 v0 = acc[ai][bj][m][0] * rs, v1 = acc[ai][bj][m][1] * rs;
#pragma unroll
                    for (int e = 0; e < 4; ++e) { const float a = fmaxf(v0[e], 0.f), b = fmaxf(v1[e], 0.f); v0[e] = a * a; v1[e] = b * b; }
                    *(u32x4*)(rowp + bj * HALF) = pack8(v0, v1); } }
    }
};
struct EpiGate {
    static constexpr bool PERM = true, AFTER_DRAIN = false, HAS_SSQ = true;
    const bf16_t* xb; bf16_t* x3b; const bf16_t* pp; const float* ssq_in; float* ssq_out;
    __device__ __forceinline__ float* ssq_dst() const { return ssq_out; }
    __device__ __forceinline__ float quad(int row, int col, f32x4 acc) const {
        const size_t off = (size_t)row * 1024 + col;
        const float rs = rsqrtf(ssq_in[row] * (1.f / 1024.f) + RMS_EPS) * (-1.4426950408889634f);
        const u32x2 xw = *(const u32x2*)(xb + off); const u32x2 pw = *(const u32x2*)(pp + off);
        const f32x4 a0 = (f32x4){bf_lo(xw.x), bf_hi(xw.x), bf_lo(xw.y), bf_hi(xw.y)}, p0 = (f32x4){bf_lo(pw.x), bf_hi(pw.x), bf_lo(pw.y), bf_hi(pw.y)}; f32x4 v;
#pragma unroll
        for (int e = 0; e < 4; ++e) v[e] = a0[e] + __builtin_amdgcn_rcpf(1.f + __builtin_amdgcn_exp2f(acc[e] * rs)) * p0[e];
        *(u32x2*)(x3b + off) = pack4(v);
        return (v[0] * v[0] + v[1] * v[1]) + (v[2] * v[2] + v[3] * v[3]); }
    __device__ __forceinline__ void operator()(const f32x4 (&acc)[2][2][4][2], const Unit& u, int wr, int wc, int fr, int fq) const {
        const int row0 = u.pm * BM + wr * 64 + fr, col0 = u.pn * BM + wc * 32 + 8 * fq;
#pragma unroll
        for (int ai = 0; ai < 2; ++ai) {
            u32x4 rx[4][2], rp[4][2]; float rs4[4];
#pragma unroll
            for (int m = 0; m < 4; ++m) { const int row = row0 + ai * HALF + m * 16; const size_t off = (size_t)row * 1024 + col0;
                rs4[m] = ssq_in[row];
#pragma unroll
                for (int bj = 0; bj < 2; ++bj) { rx[m][bj] = *(const u32x4*)(xb + off + bj * HALF); rp[m][bj] = *(const u32x4*)(pp + off + bj * HALF); } }
            float s4[4];
#pragma unroll
            for (int m = 0; m < 4; ++m) { const size_t off = (size_t)(row0 + ai * HALF + m * 16) * 1024 + col0; float s = 0.f;
                const float rs = rsqrtf(rs4[m] * (1.f / 1024.f) + RMS_EPS) * (-1.4426950408889634f);
#pragma unroll
                for (int bj = 0; bj < 2; ++bj) { f32x4 a0, a1, p0, p1; unpack8(rx[m][bj], a0, a1); unpack8(rp[m][bj], p0, p1); f32x4 v0, v1;
#pragma unroll
                    for (int e = 0; e < 4; ++e) { const float g0 = __builtin_amdgcn_rcpf(1.f + __builtin_amdgcn_exp2f(acc[ai][bj][m][0][e] * rs)), g1 = __builtin_amdgcn_rcpf(1.f + __builtin_amdgcn_exp2f(acc[ai][bj][m][1][e] * rs));
                        v0[e] = a0[e] + g0 * p0[e]; v1[e] = a1[e] + g1 * p1[e]; }
                    *(u32x4*)(x3b + off + bj * HALF) = pack8(v0, v1); s += sq8(v0, v1); }
                s += __shfl_xor(s, 16); s += __shfl_xor(s, 32); s4[m] = s; }
            if (fq == 0) {
#pragma unroll
                for (int m = 0; m < 4; ++m) atomicAdd(ssq_out + row0 + ai * HALF + m * 16, s4[m]); }
        }
    }
};
}
constexpr int NWAVES = 8;
constexpr int MP = 32768, MS = 512, M = MP + MS;
constexpr int D = 1024, NIN = 1280, FF = 4096, PLE = 256, SEQ = 16384;
#ifndef MK_N_LAUNCHES
#define MK_N_LAUNCHES 1
#endif
constexpr int N_PHASES = 8;
constexpr size_t MiB = 1u << 20;
constexpr size_t WS_CTL = 0, CTL_ZERO_BYTES = 1 * MiB;
constexpr size_t WS_SSQ1 = 0, WS_SSQ2 = 160 * 1024, WS_SSQ3 = 320 * 1024, WS_BAR = 512 * 1024;
constexpr size_t WS_WIN = 1 * MiB;
constexpr size_t WS_WO = 4 * MiB;
constexpr size_t WS_WUP = 6 * MiB;
constexpr size_t WS_WD = 14 * MiB;
constexpr size_t WS_WG = 22 * MiB;
constexpr size_t WS_WPLE = 24 * MiB;
constexpr size_t WS_WPOOL = 24 * MiB + 512 * 1024;
constexpr size_t WS_PLEB = 26 * MiB;
constexpr size_t WS_PP = 43 * MiB;
constexpr size_t WS_XB = 108 * MiB;
constexpr size_t WS_H = 173 * MiB;
constexpr size_t WS_Z = 173 * MiB;
constexpr size_t WS_MIX = 255 * MiB;
constexpr size_t WS_END = 433 * MiB;
static_assert(WS_Z + (size_t)M * NIN * 2 <= WS_MIX && WS_MIX + (size_t)M * D * 2 <= WS_END && WS_H + (size_t)M * FF * 2 <= WS_END && WS_XB + (size_t)M * D * 2 <= WS_H && WS_PP + (size_t)M * D * 2 <= WS_XB && WS_PLEB + (size_t)M * PLE * 2 <= WS_PP, "d_ws map");
constexpr int LDS_BYTES = 147456;
constexpr int MISC_OFF = 140 * 1024;
#define GAS __attribute__((address_space(1)))
#define LAS __attribute__((address_space(3)))
typedef unsigned short bf16;
typedef unsigned v4u __attribute__((ext_vector_type(4)));
typedef unsigned v2u __attribute__((ext_vector_type(2)));
typedef float f32x4 __attribute__((ext_vector_type(4)));
typedef float f32x16 __attribute__((ext_vector_type(16)));
typedef short bf16x8 __attribute__((ext_vector_type(8)));
typedef short s16x4 __attribute__((ext_vector_type(4)));
#define LDS_WAIT() asm volatile("s_waitcnt lgkmcnt(0)" ::: "memory")
__device__ __forceinline__ unsigned f2bf(float f) { unsigned u = __builtin_bit_cast(unsigned, f); return (u + 0x7fffu + ((u >> 16) & 1u)) >> 16; }
__device__ __forceinline__ unsigned pk2(float lo, float hi) { return f2bf(lo) | (f2bf(hi) << 16); }
__device__ __forceinline__ float bflo(unsigned w) { return __uint_as_float(w << 16); }
__device__ __forceinline__ float bfhi(unsigned w) { return __uint_as_float(w & 0xffff0000u); }
__device__ __forceinline__ float wave_sum(float v) {
#pragma unroll
    for (int o = 1; o < 64; o <<= 1) v += __shfl_xor(v, o);
    return v;
}

#define RLX_AGENT __ATOMIC_RELAXED, __HIP_MEMORY_SCOPE_AGENT
#define XB_TMO      128
#define XB_XCNT(j)  (256  + 64 * (j))
#define XB_XSUB(j)  (1280 + 64 * (j))
#define XB_XGEN(j)  (2304 + 64 * (j))
#define XB_TOP      3328
#define XB_TOPGEN   3392
#define XCD_BAR_WORDS 3456
#define XB_SPIN_CAP (1u << 18)

__device__ __forceinline__ unsigned xb_ld(unsigned* p)              { return __hip_atomic_load(p, __ATOMIC_RELAXED, __HIP_MEMORY_SCOPE_AGENT); }
__device__ __forceinline__ unsigned xb_add(unsigned* p, unsigned v) { return __hip_atomic_fetch_add(p, v, __ATOMIC_RELAXED, __HIP_MEMORY_SCOPE_AGENT); }
__device__ __forceinline__ unsigned xb_xcc_id() { return (unsigned)__builtin_amdgcn_s_getreg((3 << 11) | 20) & 0xFu; }
#define XB_SPIN(cond, bar) do { unsigned _sp = 0; while (cond) { __builtin_amdgcn_s_sleep(1); \
    if ((++_sp & 255u) == 0u) { if (xb_ld(&(bar)[XB_TMO])) break; if (_sp > XB_SPIN_CAP) { atomicAdd(&(bar)[XB_TMO], 1u); break; } } } } while (0)

struct XcdBarrier {
    unsigned* bar; unsigned x;
    volatile LAS unsigned* st;
};

__device__ __forceinline__ XcdBarrier xcd_barrier_post(unsigned* bar, volatile LAS unsigned* st, bool leader) {
    XcdBarrier b; b.bar = bar; b.x = xb_xcc_id(); b.st = st;
    if (leader) (void)xb_add(&bar[XB_XCNT(b.x)], 1u);
    return b;
}
__device__ __forceinline__ void xcd_barrier_complete(unsigned* bar, unsigned x, unsigned& nloc, unsigned& nx) {
    const unsigned G = gridDim.x * gridDim.y * gridDim.z;
    unsigned sum, cnt, mine, sp = 0u;
    for (;;) {
        sum = 0u; cnt = 0u; mine = 0u;
#pragma unroll
        for (unsigned j = 0; j < 16; ++j) { const unsigned c = xb_ld(&bar[XB_XCNT(j)]); sum += c; cnt += (c > 0u) ? 1u : 0u; mine = (j == x) ? c : mine; }
        if (sum == G) break;
        __builtin_amdgcn_s_sleep(1);
        if ((++sp & 255u) == 0u) { if (xb_ld(&bar[XB_TMO])) break; if (sp > XB_SPIN_CAP) { atomicAdd(&bar[XB_TMO], 1u); break; } }
    }
    nloc = mine > 0u ? mine : 1u; nx = cnt > 0u ? cnt : 1u;
}

__device__ __forceinline__ void xcd_barrier(const XcdBarrier& b, bool leader) {
    asm volatile("s_waitcnt vmcnt(0)" ::: "memory");
    __syncthreads();
    if (leader) {
        unsigned* bar = b.bar;
        __builtin_amdgcn_s_waitcnt(0);
        unsigned nloc = b.st[0], nx = b.st[1];
        if (nloc == 0u) { xcd_barrier_complete(bar, b.x, nloc, nx); b.st[0] = nloc; b.st[1] = nx; }
        const unsigned old = xb_add(&bar[XB_XSUB(b.x)], 1u);
        const unsigned gen = old / nloc;
        if (old + 1u == (gen + 1u) * nloc) {
            __builtin_amdgcn_fence(__ATOMIC_RELEASE, "agent");
            asm volatile("s_waitcnt vmcnt(0)" ::: "memory");
            const unsigned og = xb_add(&bar[XB_TOP], 1u);
            const unsigned tg = og / nx;
            if (og + 1u == (tg + 1u) * nx) xb_add(&bar[XB_TOPGEN], 1u);
            else XB_SPIN(xb_ld(&bar[XB_TOPGEN]) == tg, bar);
            __builtin_amdgcn_fence(__ATOMIC_ACQUIRE, "agent");
            xb_add(&bar[XB_XGEN(b.x)], 1u);
            asm volatile("s_waitcnt vmcnt(0)" ::: "memory");
        } else {
            XB_SPIN(xb_ld(&bar[XB_XGEN(b.x)]) == gen, bar);
            __builtin_amdgcn_fence(__ATOMIC_ACQUIRE, "agent");
            asm volatile("s_waitcnt vmcnt(0)" ::: "memory");
        }
    }
    __syncthreads();
}

struct Params { const float* in[22]; float* out; unsigned char* ws; int ph_lo, ph_hi; };
struct Frame { LAS unsigned char* lds; int tid, lane, wave, vcu, G; };
#define FRAME_LANES(F) do { (F).lane = pg8::lane_id(); (F).tid = (F).wave * 64 + (F).lane; } while (0)
typedef const __attribute__((address_space(4))) Params* KPtr;
__device__ __forceinline__ KPtr kparams() { KPtr k = (KPtr)__builtin_amdgcn_kernarg_segment_ptr(); asm volatile("" : "+s"(k)); return k; }

__device__ __forceinline__ void p0_transpose_item(const float* W, const float* g, int K, int N, bf16* WT, LAS float* scr, int item, int lane) {
    const int nblk = N / 32, kb = item / nblk, nb = item % nblk, k0 = 64 * kb, n0 = 32 * nb;
#pragma unroll 8
    for (int i = 0; i < 32; ++i) { const int kk = 2 * i + (lane >> 5); const float gv = g ? g[k0 + kk] : 1.f; scr[kk * 33 + (lane & 31)] = W[(size_t)(k0 + kk) * N + n0 + (lane & 31)] * gv; }
    LDS_WAIT(); asm volatile("" ::: "memory");
    const int c = lane & 7;
#pragma unroll
    for (int j = 0; j < 4; ++j) { const int n = (lane >> 3) + 8 * j; const LAS float* s = scr + (8 * c) * 33 + n;
        v4u o; o.x = pk2(s[0 * 33], s[1 * 33]); o.y = pk2(s[2 * 33], s[3 * 33]); o.z = pk2(s[4 * 33], s[5 * 33]); o.w = pk2(s[6 * 33], s[7 * 33]);
        *(GAS v4u*)(WT + (size_t)(n0 + n) * K + k0 + 8 * c) = o; }
    LDS_WAIT(); asm volatile("" ::: "memory");
}
__device__ __forceinline__ void p0_prologue(const Frame& F, KPtr P) {
    LAS float* scr = (LAS float*)(F.lds + F.wave * 16384);
    const int gw = F.vcu * NWAVES + F.wave, NGW = F.G * NWAVES;
    unsigned char* ws = P->ws;
    constexpr int I_IN = 16 * 40, I_O = 16 * 32, I_UP = 16 * 128, I_D = 64 * 32, I_G = 16 * 32, I_PLE = 4 * 32, I_POOL = 4 * 8;
    constexpr int NITEMS = I_IN + I_O + I_UP + I_D + I_G + I_PLE + I_POOL;
    for (int it = gw; it < NITEMS; it += NGW) {
        int r = it;
        if (r < I_UP) { p0_transpose_item(P->in[16], P->in[15], D, FF, (bf16*)(ws + WS_WUP), scr, r, F.lane); continue; } r -= I_UP;
        if (r < I_D) { p0_transpose_item(P->in[17], nullptr, FF, D, (bf16*)(ws + WS_WD), scr, r, F.lane); continue; } r -= I_D;
        if (r < I_IN) { p0_transpose_item(P->in[8], nullptr, D, NIN, (bf16*)(ws + WS_WIN), scr, r, F.lane); continue; } r -= I_IN;
        if (r < I_O) { p0_transpose_item(P->in[14], nullptr, D, D, (bf16*)(ws + WS_WO), scr, r, F.lane); continue; } r -= I_O;
        if (r < I_G) { p0_transpose_item(P->in[19], P->in[18], D, D, (bf16*)(ws + WS_WG), scr, r, F.lane); continue; } r -= I_G;
        if (r < I_PLE) { p0_transpose_item(P->in[20], nullptr, PLE, D, (bf16*)(ws + WS_WPLE), scr, r, F.lane); continue; } r -= I_PLE;
        { const int g = r >> 3; p0_transpose_item(P->in[11] + g * 16384, nullptr, 128, 128, (bf16*)(ws + WS_WPOOL) + g * 16384, scr, r & 7, F.lane); }
    }
    const float* lnm = P->in[7];
    f32x4 gv[4];
#pragma unroll
    for (int j = 0; j < 4; ++j) gv[j] = ((const f32x4*)lnm)[F.lane + 64 * j];
    bf16* XN = (bf16*)(ws + WS_XB);
    for (int m = gw; m < M; m += NGW) {
        const float* xrow = (m < MP) ? P->in[0] + (size_t)m * D : P->in[1] + (size_t)(m - MP) * D;
        const GAS f32x4* xr = (const GAS f32x4*)xrow + F.lane;
        f32x4 v[4]; float s = 0.f;
#pragma unroll
        for (int j = 0; j < 4; ++j) { v[j] = xr[64 * j]; s += (v[j].x * v[j].x + v[j].y * v[j].y) + (v[j].z * v[j].z + v[j].w * v[j].w); }
        const float rstd = rsqrtf(wave_sum(s) * (1.f / D) + pg8::RMS_EPS);
        GAS v2u* o8 = (GAS v2u*)(XN + (size_t)m * D) + F.lane;
#pragma unroll
        for (int j = 0; j < 4; ++j) { v2u o; o.x = pk2(v[j].x * rstd * gv[j].x, v[j].y * rstd * gv[j].y); o.y = pk2(v[j].z * rstd * gv[j].z, v[j].w * rstd * gv[j].w); o8[64 * j] = o; }
    }
    bf16* PB = (bf16*)(ws + WS_PLEB);
    for (int m = gw; m < M; m += NGW) {
        const float* prow = (m < MP) ? P->in[5] + (size_t)m * PLE : P->in[6] + (size_t)(m - MP) * PLE;
        const f32x4 v = ((const GAS f32x4*)prow)[F.lane];
        v2u o; o.x = pk2(v.x, v.y); o.y = pk2(v.z, v.w);
        ((GAS v2u*)(PB + (size_t)m * PLE))[F.lane] = o;
    }
}

constexpr int KSB = 272;
constexpr int L_K = 0, L_V = 192 * KSB, L_U = 0, USB = 1040  , L_SCR = 120 * 1024;
static_assert(2 * 192 * KSB <= L_SCR && 79 * USB <= L_SCR, "P2 LDS map");
__device__ __forceinline__ int crow(int r, int hi) { return (r & 3) + 8 * (r >> 2) + 4 * hi; }
__device__ __forceinline__ bf16x8 pack_step(const f32x16& x, int s) {
    v4u p; p.x = pg8::cvt_pk_bf16(x[8 * s], x[8 * s + 1]); p.y = pg8::cvt_pk_bf16(x[8 * s + 2], x[8 * s + 3]); p.z = pg8::cvt_pk_bf16(x[8 * s + 4], x[8 * s + 5]); p.w = pg8::cvt_pk_bf16(x[8 * s + 6], x[8 * s + 7]);
    return __builtin_bit_cast(bf16x8, p);
}
typedef short v4i16_t __attribute__((ext_vector_type(4)));
__device__ __forceinline__ s16x4 vtr(const LAS unsigned char* p) { return __builtin_bit_cast(s16x4, __builtin_amdgcn_ds_read_tr16_b64_v4i16((LAS v4i16_t*)p)); }

__device__ __forceinline__ void mix_unit(const Frame& F, KPtr P, int unit) {
    unsigned char* ws = P->ws;
    const bf16* Z = (const bf16*)(ws + WS_Z);
    bf16* MIX = (bf16*)(ws + WS_MIX);
    const int tid = F.tid, lane = F.lane, wave = F.wave, r32 = lane & 31, hi = lane >> 5;
    LAS unsigned char* lds = F.lds;
    const bool prompt = unit < 512;
    int qrow0, nq, kmin, kmax, pos0, sb = 0;
    if (prompt) { const int b = unit >> 8, c = unit & 255; qrow0 = b * SEQ + c * 64; nq = 64; kmin = (c >= 2) ? 0 : (2 - c) * 64; kmax = 192; pos0 = c * 64; }
    else { sb = unit - 512; qrow0 = MP + sb * 16; nq = 16; kmin = 0; kmax = 144; pos0 = 2048; }
    const int nqt = (nq + 31) >> 5;
    for (int p = tid; p < 192 * 32; p += NWAVES * 64) {
        const int row = p >> 5, cp = p & 31;
        v4u val = (v4u){0u, 0u, 0u, 0u};
        if (row >= kmin && row < kmax) {
            if (prompt) val = *(const GAS v4u*)(Z + (size_t)(qrow0 - 128 + row) * NIN + 512 + cp * 8);
            else if (row >= 128) val = *(const GAS v4u*)(Z + (size_t)(qrow0 + row - 128) * NIN + 512 + cp * 8);
            else { const float* src = ((cp < 16) ? P->in[2] : P->in[3]) + (size_t)(sb * 128 + row) * 128 + (cp & 15) * 8;
                const f32x4 a = *(const GAS f32x4*)src, b2 = *(const GAS f32x4*)(src + 4);
                val.x = pk2(a.x, a.y); val.y = pk2(a.z, a.w); val.z = pk2(b2.x, b2.y); val.w = pk2(b2.z, b2.w); }
        }
        *(LAS v4u*)(lds + ((cp < 16) ? L_K : L_V) + row * KSB + (cp & 15) * 16) = val;
    }
    __syncthreads();
    const int hd = wave, kvh = wave >> 2;
    const float sink2 = P->in[9][hd] * 1.4426950408889634f;
    LAS float* scr = (LAS float*)(lds + L_SCR);
    float biasv[6][2];
#pragma unroll
    for (int j = 0; j < 6; ++j)
#pragma unroll
        for (int rh = 0; rh < 2; ++rh) { const int k0 = 32 * j + 16 * rh; biasv[j][rh] = (k0 >= kmin && k0 < kmax) ? 0.f : -INFINITY; }
    const float* ga = P->in[10];
#ifndef NO_ATT
#pragma unroll 1
    for (int qt = 0; qt < nqt; ++qt) {
        f32x16 o[2];
#pragma unroll
        for (int db = 0; db < 2; ++db)
#pragma unroll
            for (int r = 0; r < 16; ++r) o[db][r] = 0.f;
        const int ql = 32 * qt + r32; const int qrow = qrow0 + (ql < nq ? ql : 0);
        bf16x8 qr[4];
#pragma unroll
        for (int ds = 0; ds < 4; ++ds) qr[ds] = *(const GAS bf16x8*)(Z + (size_t)qrow * NIN + hd * 64 + ds * 16 + hi * 8);
        float mx = sink2;
#pragma unroll
        for (int j = 0; j < 6; ++j) {
            f32x16 T;
#pragma unroll
            for (int r = 0; r < 16; ++r) T[r] = biasv[j][r >> 3];
#pragma unroll
            for (int ds = 0; ds < 4; ++ds) { const bf16x8 kf = *(const LAS bf16x8*)(lds + L_K + (32 * j + r32) * KSB + (kvh * 64 + ds * 16 + hi * 8) * 2);
                T = __builtin_amdgcn_mfma_f32_32x32x16_bf16(kf, qr[ds], T, 0, 0, 0); }
#pragma unroll
            for (int r = 0; r < 16; ++r) mx = fmaxf(mx, T[r]);
        }
        mx = fmaxf(mx, __shfl_xor(mx, 32));
        float ls = 0.f;
        const int i16 = lane & 15, qd = i16 >> 2, pp4 = i16 & 3, blk = (lane >> 4) & 1;
        const LAS unsigned char* vbase = lds + L_V + (4 * hi + qd) * KSB + (kvh * 64 + 16 * blk + 4 * pp4) * 2;
#pragma unroll
        for (int j = 0; j < 6; ++j) {
            f32x16 T;
#pragma unroll
            for (int r = 0; r < 16; ++r) T[r] = biasv[j][r >> 3] - mx;
#pragma unroll
            for (int ds = 0; ds < 4; ++ds) { const bf16x8 kf = *(const LAS bf16x8*)(lds + L_K + (32 * j + r32) * KSB + (kvh * 64 + ds * 16 + hi * 8) * 2);
                T = __builtin_amdgcn_mfma_f32_32x32x16_bf16(kf, qr[ds], T, 0, 0, 0); }
#pragma unroll
            for (int r = 0; r < 16; ++r) { T[r] = __builtin_amdgcn_exp2f(T[r]); ls += T[r]; }
#pragma unroll
            for (int s = 0; s < 2; ++s) { const bf16x8 pf = pack_step(T, s);
#pragma unroll
                for (int db = 0; db < 2; ++db) { const LAS unsigned char* vp = vbase + (32 * j + 16 * s) * KSB + 64 * db;
                    const s16x4 lo = vtr(vp), hi4 = vtr(vp + 8 * KSB);
                    const bf16x8 vf = __builtin_shufflevector(lo, hi4, 0, 1, 2, 3, 4, 5, 6, 7);
                    o[db] = __builtin_amdgcn_mfma_f32_32x32x16_bf16(vf, pf, o[db], 0, 0, 0); } }
        }
        ls += __shfl_xor(ls, 32);
        const float inv = 1.f / (ls + __builtin_amdgcn_exp2f(sink2 - mx));
        float sq = 0.f;
#pragma unroll
        for (int db = 0; db < 2; ++db)
#pragma unroll
            for (int r = 0; r < 16; ++r) { o[db][r] *= inv; sq += o[db][r] * o[db][r]; }
        sq += __shfl_xor(sq, 32);
        if (hi == 0) scr[wave * 32 + r32] = sq;
        __syncthreads();
        float tot = 0.f;
#pragma unroll
        for (int w = 0; w < 8; ++w) tot += scr[w * 32 + r32];
        const float rstd = rsqrtf(tot * (1.f / 512.f) + pg8::RMS_EPS);
        if (ql < nq) { bf16* orow = MIX + (size_t)(qrow0 + ql) * D + hd * 64;
#pragma unroll
            for (int db = 0; db < 2; ++db)
#pragma unroll
                for (int rg = 0; rg < 4; ++rg) { const int d0 = 32 * db + 8 * rg + 4 * hi; const f32x4 g = *(const f32x4*)(ga + hd * 64 + d0);
                    v2u w; w.x = pk2(o[db][4 * rg] * rstd * g.x, o[db][4 * rg + 1] * rstd * g.y); w.y = pk2(o[db][4 * rg + 2] * rstd * g.z, o[db][4 * rg + 3] * rstd * g.w);
                    *(GAS v2u*)(orow + d0) = w; } }
        __syncthreads();
    }
#endif
#ifndef NO_POOL
    for (int p = tid; p < 79 * 64; p += NWAVES * 64) {
        const int i = p >> 6, cp = p & 63;
        v4u val = (v4u){0u, 0u, 0u, 0u};
        if (i < 15 + nq) {
            if (i >= 15) val = *(const GAS v4u*)(Z + (size_t)(qrow0 + i - 15) * NIN + 768 + cp * 8);
            else if (prompt) { if (pos0 > 0) val = *(const GAS v4u*)(Z + (size_t)(qrow0 + i - 15) * NIN + 768 + cp * 8); }
            else { const float* src = P->in[4] + (size_t)(sb * 15 + i) * 512 + cp * 8; const f32x4 a = *(const GAS f32x4*)src, b2 = *(const GAS f32x4*)(src + 4);
                val.x = pk2(a.x, a.y); val.y = pk2(a.z, a.w); val.z = pk2(b2.x, b2.y); val.w = pk2(b2.z, b2.w); }
        }
        *(LAS v4u*)(lds + L_U + i * USB + cp * 16) = val;
    }
    __syncthreads();
    {
        const int g = wave >> 1, eh = wave & 1, w = 2 << g;
        const bf16* WpT = (const bf16*)(ws + WS_WPOOL) + g * 16384;
        const float* psc = P->in[12]; const float* gp = P->in[13];
        f32x16 bacc[2][2];
        float ssqb[2];
#pragma unroll
        for (int tt = 0; tt < 2; ++tt) {
            ssqb[tt] = 0.f;
#pragma unroll
            for (int et = 0; et < 2; ++et)
#pragma unroll
                for (int r = 0; r < 16; ++r) bacc[tt][et][r] = 0.f;
            if (tt < nqt) {
                const int t = 32 * tt + r32;
                const int pc = pos0 + t + 1; const float icnt = 1.f / (float)(pc < w ? pc : w);
#pragma unroll 2
                for (int ks = 0; ks < 8; ++ks) {
                    const int c = g * 128 + 16 * ks + 8 * hi;
                    const LAS unsigned char* up = lds + L_U + (15 + t) * USB + c * 2;
                    float sum[8];
#pragma unroll
                    for (int e = 0; e < 8; ++e) sum[e] = 0.f;
                    for (int i = 0; i < w; ++i) { const v4u x = *(const LAS v4u*)(up - i * USB);
                        sum[0] += bflo(x.x); sum[1] += bfhi(x.x); sum[2] += bflo(x.y); sum[3] += bfhi(x.y); sum[4] += bflo(x.z); sum[5] += bfhi(x.z); sum[6] += bflo(x.w); sum[7] += bfhi(x.w); }
                    const v4u x0 = *(const LAS v4u*)up;
                    v4u dv; dv.x = pk2(sum[0] * icnt - bflo(x0.x), sum[1] * icnt - bfhi(x0.x)); dv.y = pk2(sum[2] * icnt - bflo(x0.y), sum[3] * icnt - bfhi(x0.y));
                    dv.z = pk2(sum[4] * icnt - bflo(x0.z), sum[5] * icnt - bfhi(x0.z)); dv.w = pk2(sum[6] * icnt - bflo(x0.w), sum[7] * icnt - bfhi(x0.w));
                    const bf16x8 df = __builtin_bit_cast(bf16x8, dv);
#pragma unroll
                    for (int et = 0; et < 2; ++et) { const bf16x8 wf = *(const GAS bf16x8*)(WpT + (size_t)(64 * eh + 32 * et + r32) * 128 + 16 * ks + 8 * hi);
                        bacc[tt][et] = __builtin_amdgcn_mfma_f32_32x32x16_bf16(wf, df, bacc[tt][et], 0, 0, 0); }
                }
                float sq = 0.f;
#pragma unroll
                for (int et = 0; et < 2; ++et)
#pragma unroll
                    for (int rg = 0; rg < 4; ++rg) { const f32x4 sc = *(const f32x4*)(psc + g * 128 + 64 * eh + 32 * et + 8 * rg + 4 * hi);
#pragma unroll
                        for (int e = 0; e < 4; ++e) { const float v = bacc[tt][et][4 * rg + e] * sc[e]; bacc[tt][et][4 * rg + e] = v; sq += v * v; } }
                sq += __shfl_xor(sq, 32);
                ssqb[tt] = sq;
            }
        }
        if (hi == 0) { scr[512 + (0 * 8 + wave) * 32 + r32] = ssqb[0]; scr[512 + (1 * 8 + wave) * 32 + r32] = ssqb[1]; }
        __syncthreads();
#pragma unroll
        for (int tt = 0; tt < 2; ++tt) if (tt < nqt) {
            float tot = 0.f;
#pragma unroll
            for (int w2 = 0; w2 < 8; ++w2) tot += scr[512 + (tt * 8 + w2) * 32 + r32];
            const float rstd = rsqrtf(tot * (1.f / 512.f) + pg8::RMS_EPS);
            const int t = 32 * tt + r32;
            if (t < nq) { bf16* orow = MIX + (size_t)(qrow0 + t) * D + 512 + g * 128 + 64 * eh;
#pragma unroll
                for (int et = 0; et < 2; ++et)
#pragma unroll
                    for (int rg = 0; rg < 4; ++rg) { const int e0 = 32 * et + 8 * rg + 4 * hi; const f32x4 gg = *(const f32x4*)(gp + g * 128 + 64 * eh + e0);
                        v2u wv; wv.x = pk2(bacc[tt][et][4 * rg] * rstd * gg.x, bacc[tt][et][4 * rg + 1] * rstd * gg.y); wv.y = pk2(bacc[tt][et][4 * rg + 2] * rstd * gg.z, bacc[tt][et][4 * rg + 3] * rstd * gg.w);
                        *(GAS v2u*)(orow + e0) = wv; } }
        }
    }
    __syncthreads();
#endif
}


typedef float f32x4t __attribute__((ext_vector_type(4)));
template <class Epi>
__device__ __forceinline__ void tail_gemm(const Frame& F, const bf16* A, const bf16* Bt, int N, int K, const Epi& E) {
    const int lane = F.lane, wave = F.wave, tid = F.tid, c16 = lane & 15, g4 = lane >> 4;
    LAS float* red = (LAS float*)F.lds;
    const int ntiles = 32 * (N >> 7), kw = K >> 3;
    for (int tile = F.vcu; tile < ntiles; tile += F.G) {
        const int mt = tile & 31, nt = tile >> 5;
        f32x4t acc[8];
#pragma unroll
        for (int j = 0; j < 8; ++j) acc[j] = (f32x4t){0.f, 0.f, 0.f, 0.f};
        const bf16* ap = A + (size_t)(mt * 16 + c16) * K + wave * kw + 8 * g4;
        const bf16* bp = Bt + (size_t)(nt * 128 + c16) * K + wave * kw + 8 * g4;
#pragma unroll 4
        for (int k = 0; k < kw; k += 32) {
            const bf16x8 a = *(const GAS bf16x8*)(ap + k);
#pragma unroll
            for (int j = 0; j < 8; ++j) { const bf16x8 b = *(const GAS bf16x8*)(bp + (size_t)(16 * j) * K + k);
                acc[j] = __builtin_amdgcn_mfma_f32_16x16x32_bf16(b, a, acc[j], 0, 0, 0); }
        }
#pragma unroll
        for (int j = 0; j < 8; ++j) *(LAS f32x4t*)(red + (wave * 16 + c16) * 132 + 16 * j + 4 * g4) = acc[j];
        __syncthreads();
        const int row = tid >> 5, cg4 = (tid & 31) * 4;
        f32x4t v = (f32x4t){0.f, 0.f, 0.f, 0.f};
#pragma unroll
        for (int w = 0; w < 8; ++w) v += *(const LAS f32x4t*)(red + (w * 16 + row) * 132 + cg4);
        float sq = E.quad(MP + mt * 16 + row, nt * 128 + cg4, v);
        if (Epi::HAS_SSQ) {
#pragma unroll
            for (int o = 1; o < 32; o <<= 1) sq += __shfl_xor(sq, o);
            if ((lane & 31) == 0) atomicAdd(E.ssq_dst() + MP + mt * 16 + row, sq);
        }
        __syncthreads();
    }
}

__device__ __forceinline__ void p7_final(const Frame& F, KPtr P) {
    const int gw = F.vcu * NWAVES + F.wave, NGW = F.G * NWAVES;
    const float* ssq3 = (const float*)(P->ws + WS_SSQ3); const float* gf = P->in[21]; const bf16* X3 = (const bf16*)(P->ws + WS_Z); float* out = P->out;
    f32x4 gv[4];
#pragma unroll
    for (int j = 0; j < 4; ++j) gv[j] = ((const f32x4*)gf)[F.lane + 64 * j];
    for (int m = gw; m < M; m += NGW) {
        const GAS v2u* xr = (const GAS v2u*)(X3 + (size_t)m * D) + F.lane;
        GAS f32x4* yr = (GAS f32x4*)(out + (size_t)m * D) + F.lane;
        const float rstd = rsqrtf(ssq3[m] * (1.f / D) + pg8::RMS_EPS);
        v2u w[4];
#pragma unroll
        for (int j = 0; j < 4; ++j) w[j] = xr[64 * j];
#pragma unroll
        for (int j = 0; j < 4; ++j) { f32x4 v = (f32x4){bflo(w[j].x), bfhi(w[j].x), bflo(w[j].y), bfhi(w[j].y)}; yr[64 * j] = v * rstd * gv[j]; }
    }
}

__global__ void __launch_bounds__(NWAVES * 64, 2) trunk_fwd(Params Pv) {
    extern __shared__ __attribute__((aligned(16))) unsigned char lds[];
    Frame F;
    F.lds = (LAS unsigned char*)lds;
    { int t_ = (int)threadIdx.x; asm volatile("" : "+v"(t_)); F.wave = __builtin_amdgcn_readfirstlane(t_ >> 6); } F.tid = 0; F.lane = 0;
    F.G = gridDim.x; { const int bx = blockIdx.x; F.vcu = (F.G % 8 == 0) ? (bx % 8) * (F.G / 8) + bx / 8 : bx; }
    unsigned char* ws = kparams()->ws;
    const int lo = kparams()->ph_lo, hi = kparams()->ph_hi;
#ifndef PHASE_MASK
#define PHASE_MASK 255
#endif
#define IN(k) (((PHASE_MASK >> (k)) & 1) && lo <= (k) && (k) < hi)
    if (lo < 0) cg::this_grid().sync();
    volatile LAS unsigned* MISC = (volatile LAS unsigned*)(F.lds + MISC_OFF);
    if (pg8::lane_id() < 2 && F.wave == 0) MISC[pg8::lane_id()] = 0u;
    __syncthreads();
    XcdBarrier bar; bar.bar = (unsigned*)(ws + WS_BAR); bar.x = 0; bar.st = MISC;
    if (hi - lo > 2) bar = xcd_barrier_post((unsigned*)(ws + WS_BAR), MISC, F.wave == 0 && pg8::lane_id() == 0);
#define SEAM(k) do { if (IN(k) && IN((k) + 1)) xcd_barrier(bar, F.wave == 0 && pg8::lane_id() == 0); } while (0)
    float* ssq1 = (float*)(ws + WS_SSQ1); float* ssq2 = (float*)(ws + WS_SSQ2); float* ssq3 = (float*)(ws + WS_SSQ3);
    bf16* XB = (bf16*)(ws + WS_XB);

    if (IN(0)) { FRAME_LANES(F); p0_prologue(F, kparams()); }
    SEAM(0);
    if (IN(1)) {
        { pg8::Gemm g{XB, (const bf16*)(ws + WS_WIN), MP, NIN, D}; pg8::StaticOrder S; S.init(MP, NIN, F.G, (int)blockIdx.x);
          pg8::EpiIn E{(bf16*)(ws + WS_Z), kparams()->out};
          pg8::gemm_phase<pg8::EpiIn, pg8::StaticOrder, true, true>(F.lds, g, S, E, F.wave); }
        { pg8::Gemm g{(const bf16*)(ws + WS_PLEB), (const bf16*)(ws + WS_WPLE), MP, D, PLE}; pg8::StaticOrder S;
          if (F.G == 256) S.init(MP, D, 128, (int)blockIdx.x >= 128 ? (int)blockIdx.x - 128 : (1 << 24)); else S.init(MP, D, F.G, (int)blockIdx.x);
          pg8::EpiPlain E{(bf16*)(ws + WS_PP), D};
          pg8::gemm_phase<pg8::EpiPlain, pg8::StaticOrder, true, true>(F.lds, g, S, E, F.wave); }
        FRAME_LANES(F);
        { pg8::EpiIn E{(bf16*)(ws + WS_Z), kparams()->out}; tail_gemm(F, XB + (size_t)MP * D, (const bf16*)(ws + WS_WIN), NIN, D, E); }
        { pg8::EpiPlain E{(bf16*)(ws + WS_PP), D}; tail_gemm(F, (const bf16*)(ws + WS_PLEB) + (size_t)MP * PLE, (const bf16*)(ws + WS_WPLE), D, PLE, E); }
    }
    SEAM(1);
    if (IN(2)) {
        FRAME_LANES(F); for (int u = F.vcu; u < 544; u += F.G) mix_unit(F, kparams(), u);
    }
    SEAM(2);
    if (IN(3)) {
        pg8::Gemm g{(const bf16*)(ws + WS_MIX), (const bf16*)(ws + WS_WO), MP, D, D}; pg8::StaticOrder S; S.init(MP, D, F.G, (int)blockIdx.x);
        KPtr P = kparams(); pg8::EpiRes1 E{P->in[0], P->in[1], XB, ssq1};
        pg8::gemm_phase<pg8::EpiRes1, pg8::StaticOrder, true, true>(F.lds, g, S, E, F.wave);
        FRAME_LANES(F); tail_gemm(F, (const bf16*)(ws + WS_MIX) + (size_t)MP * D, (const bf16*)(ws + WS_WO), D, D, E);
    }
    SEAM(3);
    if (IN(4)) {
        pg8::Gemm g{XB, (const bf16*)(ws + WS_WUP), MP, FF, D}; pg8::StaticOrder S; S.init(MP, FF, F.G, (int)blockIdx.x);
        pg8::EpiUp E{(bf16*)(ws + WS_H), ssq1};
        pg8::gemm_phase<pg8::EpiUp, pg8::StaticOrder, true, true>(F.lds, g, S, E, F.wave);
        FRAME_LANES(F); tail_gemm(F, XB + (size_t)MP * D, (const bf16*)(ws + WS_WUP), FF, D, E);
    }
    SEAM(4);
    if (IN(5)) {
        pg8::Gemm g{(const bf16*)(ws + WS_H), (const bf16*)(ws + WS_WD), MP, D, FF}; pg8::StaticOrder S; S.init(MP, D, F.G, (int)blockIdx.x);
        pg8::EpiRes2 E{XB, ssq2};
        pg8::gemm_phase<pg8::EpiRes2, pg8::StaticOrder, true, true>(F.lds, g, S, E, F.wave);
        FRAME_LANES(F); tail_gemm(F, (const bf16*)(ws + WS_H) + (size_t)MP * FF, (const bf16*)(ws + WS_WD), D, FF, E);
    }
    SEAM(5);
    if (IN(6)) {
        pg8::Gemm g{XB, (const bf16*)(ws + WS_WG), MP, D, D}; pg8::StaticOrder S; S.init(MP, D, F.G, (int)blockIdx.x);
        pg8::EpiGate E{XB, (bf16*)(ws + WS_Z), (const bf16*)(ws + WS_PP), ssq2, ssq3};
        pg8::gemm_phase<pg8::EpiGate, pg8::StaticOrder, true, true>(F.lds, g, S, E, F.wave);
        FRAME_LANES(F); tail_gemm(F, XB + (size_t)MP * D, (const bf16*)(ws + WS_WG), D, D, E);
    }
    SEAM(6);
    if (IN(7)) { FRAME_LANES(F); p7_final(F, kparams()); }
#undef IN
#undef SEAM
}

extern "C" void kernel_launch(void* const* d_in, const int* in_sizes, int n_in, void* d_out, int out_size, void* d_ws, size_t ws_size, hipStream_t stream) {
    static int grid = 0;
    if (grid == 0) {
        if (n_in != 22 || in_sizes[0] != MP * D || out_size != 34536448 || ws_size < WS_END) { fprintf(stderr, "kernel_launch: unexpected shapes: n_in %d in0 %d out %d ws %zu (need %zu)\n", n_in, n_in > 0 ? in_sizes[0] : -1, out_size, ws_size, (size_t)WS_END); grid = -1; return; }
        int dev = 0, cus = 0, per_cu = 0;
        if (hipGetDevice(&dev) != hipSuccess || hipDeviceGetAttribute(&cus, hipDeviceAttributeMultiprocessorCount, dev) != hipSuccess) { grid = -1; return; }
        if (hipFuncSetAttribute((const void*)trunk_fwd, hipFuncAttributeMaxDynamicSharedMemorySize, LDS_BYTES) != hipSuccess) { fprintf(stderr, "kernel_launch: hipFuncSetAttribute failed\n"); grid = -1; return; }
        if (hipOccupancyMaxActiveBlocksPerMultiprocessor(&per_cu, (const void*)trunk_fwd, NWAVES * 64, LDS_BYTES) != hipSuccess || per_cu < 1) { fprintf(stderr, "kernel_launch: occupancy query says %d blocks per CU\n", per_cu); (void)hipGetLastError(); grid = -1; return; }
        grid = cus;
    }
    if (grid < 0) return;
    (void)hipMemsetAsync((char*)d_ws + WS_CTL, 0, CTL_ZERO_BYTES, stream);
    Params p{};
    for (int i = 0; i < 22; ++i) p.in[i] = (const float*)d_in[i];
    p.out = (float*)d_out; p.ws = (unsigned char*)d_ws;
#if MK_N_LAUNCHES == 1
    p.ph_lo = 0; p.ph_hi = N_PHASES;
    void* args[] = {&p};
    hipError_t e = hipLaunchCooperativeKernel((const void*)trunk_fwd, dim3(grid), dim3(NWAVES * 64), args, LDS_BYTES, stream);
    if (e != hipSuccess) fprintf(stderr, "kernel_launch: cooperative launch failed: %s (grid %d)\n", hipGetErrorString(e), grid);
#else
    for (int li = 0; li < N_PHASES; ++li) { p.ph_lo = li; p.ph_hi = li + 1; hipLaunchKernelGGL(trunk_fwd, dim3(grid), dim3(NWAVES * 64), LDS_BYTES, stream, p); }
#endif
}
```

```cpp
#include <hip/hip_runtime.h>
#include <hip/hip_cooperative_groups.h>
#include <hip/hip_bf16.h>
#include <cstdio>
#include <cstdint>
namespace cg = cooperative_groups;
namespace pg8 {
#define PG8_LAS __attribute__((address_space(3)))
typedef unsigned short bf16_t;
typedef short bf16x8 __attribute__((ext_vector_type(8)));
typedef float f32x4 __attribute__((ext_vector_type(4)));
typedef unsigned u32x4 __attribute__((ext_vector_type(4)));
constexpr int BM = 256, BK = 64, HALF = 128, HTB = HALF * BK * 2  , STAGE_BYTES = 8 * HTB, NXCD = 8, WGM = 8;

__host__ __device__ __forceinline__ int lds_byte(int r, int c) { const int st = (r >> 4) * 2 + (c >> 5), rr = r & 15, cc = c & 31, ob = rr * 64 + cc * 2; return st * 1024 + (ob ^ (((ob >> 9) & 1) << 5)); }
__host__ __device__ __forceinline__ void stage_rc(int b, int& R, int& C) { const int st = b / 1024, sb = b % 1024, swz = sb ^ (((sb >> 9) & 1) << 5); R = (st >> 1) * 16 + swz / 64; C = (st & 1) * 32 + (swz % 64) / 2; }
__host__ __device__ __forceinline__ int perm32(int rho) { const int n = rho >> 4, i = rho & 15; return 8 * (i >> 2) + 4 * n + (i & 3); }

struct Unit { int pm, pn; };
struct Gemm { const bf16_t* A; const bf16_t* Bt; int M, N, K; };

struct StaticOrder {
    int nM, nN, nwg, G, c, pm0;
    __host__ __device__ void init(int M, int N, int G_, int c_, int pm0_ = 0) { nM = M / BM; nN = N / BM; nwg = nM * nN; G = G_; c = c_; pm0 = pm0_; }
    __host__ __device__ bool next(int i, Unit& u) const {
        const long L = (long)i * G + c; if (L >= nwg) return false;
        int wgid = (int)L; { const int q = nwg / NXCD, r = nwg % NXCD, xcd = wgid % NXCD, off = wgid / NXCD; wgid = (xcd < r ? xcd * (q + 1) : r * (q + 1) + (xcd - r) * q) + off; }
        const int nig = WGM * nN, gid = wgid / nig, fm = gid * WGM, gsz = (nM - fm) < WGM ? (nM - fm) : WGM;
        u.pm = pm0 + fm + ((wgid % nig) % gsz); u.pn = (wgid % nig) / gsz; return true;
    }
    __device__ __forceinline__ void a_ready(const Unit&) const {}
    __device__ __forceinline__ void done(const Unit&) const {}
};

__device__ __forceinline__ unsigned cvt_pk_bf16(float lo, float hi) { unsigned r; asm volatile("v_cvt_pk_bf16_f32 %0, %1, %2" : "=v"(r) : "v"(lo), "v"(hi)); return r; }
typedef float f32x2 __attribute__((ext_vector_type(2)));
__device__ __forceinline__ int lane_id() { int l; asm volatile("v_mbcnt_lo_u32_b32 %0, -1, 0\n\tv_mbcnt_hi_u32_b32 %0, -1, %0" : "=v"(l)); return l; }
template <class Epi, class Sched, bool ALIGN_EPI = false, bool SP2 = false>
__device__ __forceinline__ void gemm_phase(PG8_LAS unsigned char* lds, const Gemm g, const Sched& S, const Epi& E, int wave_in) {
    const int wid = __builtin_amdgcn_readfirstlane(wave_in), lane = lane_id(), tid = wid * 64 + lane, wr = wid >> 2, wc = wid & 3, fr = lane & 15, fq = lane >> 4;
    const int K = g.K, nt = K / BK;
    unsigned voffA[2], voffB[2];
#pragma unroll
    for (int i = 0; i < 2; ++i) { int R, C; stage_rc(tid * 16 + i * 8192, R, C); const int Rb = Epi::PERM ? ((R & ~31) + perm32(R & 31)) : R;
        voffA[i] = (unsigned)(R * K + C) * 2u; voffB[i] = (unsigned)(Rb * K + C) * 2u; }
    const size_t kstep = (size_t)(BK * 2);
    const size_t hstep = (size_t)HALF * K * 2;
    const size_t tstep = 2 * hstep;
    const unsigned ldsw = (unsigned)wid * 1024u;
    const int aoff = lds_byte(wr * 64 + fr, fq * 8), boff = lds_byte(wc * 32 + fr, fq * 8);
#define PG8_SA(b, h) (((b) * 2 + (h)) * HTB)
#define PG8_SB(b, h) ((4 + (b) * 2 + (h)) * HTB)
#define PG8_STAGE(bufoff, gbase, voff) do { _Pragma("unroll") for (int _i = 0; _i < 2; ++_i) \
        __builtin_amdgcn_global_load_lds((const unsigned*)((const char*)(gbase) + (voff)[_i]), (PG8_LAS unsigned*)(lds + (bufoff) + ldsw + _i * 8192), 16, 0, 0); } while (0)
#define PG8_LDA(dst, b, h) do { _Pragma("unroll") for (int m = 0; m < 4; ++m) _Pragma("unroll") for (int k = 0; k < 2; ++k) dst[m][k] = *(const PG8_LAS bf16x8*)(lds + PG8_SA(b, h) + aoff + m * 2048 + k * 1024); } while (0)
#define PG8_LDB(dst, b, h) do { _Pragma("unroll") for (int n = 0; n < 2; ++n) _Pragma("unroll") for (int k = 0; k < 2; ++k) dst[n][k] = *(const PG8_LAS bf16x8*)(lds + PG8_SB(b, h) + boff + n * 2048 + k * 1024); } while (0)
#define PG8_MMA(ai, bj, At, Bt) do { __builtin_amdgcn_s_setprio(1); _Pragma("unroll") for (int m = 0; m < 4; ++m) _Pragma("unroll") for (int n = 0; n < 2; ++n) _Pragma("unroll") for (int k = 0; k < 2; ++k) \
        acc[ai][bj][m][n] = __builtin_amdgcn_mfma_f32_16x16x32_bf16(Bt[n][k], At[m][k], acc[ai][bj][m][n], 0, 0, 0); __builtin_amdgcn_s_setprio(0); } while (0)
#define PG8_WAIT_V(n) asm volatile("s_waitcnt vmcnt(" #n ")" ::: "memory")
#define PG8_WAIT_L(n) asm volatile("s_waitcnt lgkmcnt(" #n ")" ::: "memory")
#define PG8_BAR __builtin_amdgcn_s_barrier()
#define PG8_SCHED __builtin_amdgcn_sched_barrier(0)
    Unit cur, nxt; int ui = 0;
    if (!S.next(0, cur)) return;
    f32x4 acc[2][2][4][2];
#pragma unroll
    for (int a = 0; a < 2; ++a)
#pragma unroll
        for (int b = 0; b < 2; ++b)
#pragma unroll
            for (int m = 0; m < 4; ++m)
#pragma unroll
                for (int n = 0; n < 2; ++n) acc[a][b][m][n] = (f32x4){0.f, 0.f, 0.f, 0.f};
    bf16x8 At[4][2], B0[2][2], B1[2][2];
    const char* cA = (const char*)g.A + (size_t)cur.pm * tstep; const char* cB = (const char*)g.Bt + (size_t)cur.pn * tstep;
    S.a_ready(cur);
    if constexpr (SP2) {
        PG8_STAGE(PG8_SB(0, 0), cB, voffB); PG8_STAGE(PG8_SB(0, 1), cB + hstep, voffB); PG8_STAGE(PG8_SA(0, 0), cA, voffA); PG8_STAGE(PG8_SA(0, 1), cA + hstep, voffA);
        if (wr == 1) PG8_BAR;
        PG8_WAIT_V(2); PG8_BAR;
        PG8_STAGE(PG8_SB(1, 0), cB + kstep, voffB); PG8_STAGE(PG8_SA(1, 0), cA + kstep, voffA); PG8_STAGE(PG8_SB(1, 1), cB + hstep + kstep, voffB);
        PG8_WAIT_V(6); PG8_BAR;
    } else {
        PG8_STAGE(PG8_SB(0, 0), cB, voffB); PG8_STAGE(PG8_SA(0, 0), cA, voffA); PG8_STAGE(PG8_SB(0, 1), cB + hstep, voffB); PG8_STAGE(PG8_SA(0, 1), cA + hstep, voffA);
        if (wr == 1) PG8_BAR;
        PG8_WAIT_V(4); PG8_BAR;
        PG8_STAGE(PG8_SB(1, 0), cB + kstep, voffB); PG8_STAGE(PG8_SA(1, 0), cA + kstep, voffA); PG8_STAGE(PG8_SB(1, 1), cB + hstep + kstep, voffB);
        PG8_WAIT_V(6); PG8_BAR;
    }
    for (;;) {
        const bool has_next = S.next(ui + 1, nxt);
        const char* nA = has_next ? (const char*)g.A + (size_t)nxt.pm * tstep : cA; const char* nB = has_next ? (const char*)g.Bt + (size_t)nxt.pn * tstep : cB;
        for (int t = 0; t < nt; t += 2) {
            const bool last = (t == nt - 2);
            const char* a1 = cA + (size_t)(t + 1) * kstep;
            const char* a2 = last ? nA : cA + (size_t)(t + 2) * kstep; const char* b2 = last ? nB : cB + (size_t)(t + 2) * kstep;
            const char* a3 = a2 + kstep; const char* b3 = b2 + kstep;
            if (last && has_next) S.a_ready(nxt);
            if constexpr (SP2) {
            PG8_LDB(B0, 0, 0); PG8_LDB(B1, 0, 1); PG8_SCHED; PG8_LDA(At, 0, 0); PG8_STAGE(PG8_SA(1, 1), a1 + hstep, voffA);
            PG8_WAIT_V(8); PG8_WAIT_L(0); PG8_BAR; PG8_MMA(0, 0, At, B0); PG8_MMA(0, 1, At, B1); PG8_BAR; PG8_SCHED;
            PG8_LDA(At, 0, 1); PG8_STAGE(PG8_SB(0, 0), b2, voffB); PG8_STAGE(PG8_SB(0, 1), b2 + hstep, voffB); PG8_STAGE(PG8_SA(0, 0), a2, voffA);
            PG8_WAIT_V(8); PG8_WAIT_L(0); PG8_BAR; PG8_MMA(1, 0, At, B0); PG8_MMA(1, 1, At, B1); PG8_BAR; PG8_SCHED;
            PG8_LDB(B0, 1, 0); PG8_LDB(B1, 1, 1); PG8_SCHED; PG8_LDA(At, 1, 0); PG8_STAGE(PG8_SA(0, 1), a2 + hstep, voffA);
            PG8_WAIT_V(8); PG8_WAIT_L(0); PG8_BAR; PG8_MMA(0, 0, At, B0); PG8_MMA(0, 1, At, B1); PG8_BAR; PG8_SCHED;
            PG8_LDA(At, 1, 1); PG8_STAGE(PG8_SB(1, 0), b3, voffB); PG8_STAGE(PG8_SB(1, 1), b3 + hstep, voffB); PG8_STAGE(PG8_SA(1, 0), a3, voffA);
            PG8_WAIT_V(8); PG8_WAIT_L(0); PG8_BAR; PG8_MMA(1, 0, At, B0); PG8_MMA(1, 1, At, B1); PG8_BAR; PG8_SCHED;
            } else {
            PG8_LDB(B0, 0, 0); PG8_SCHED; PG8_LDA(At, 0, 0); PG8_STAGE(PG8_SA(1, 1), a1 + hstep, voffA);
            PG8_WAIT_L(8); PG8_BAR; PG8_WAIT_L(0); PG8_MMA(0, 0, At, B0); PG8_BAR; PG8_SCHED;
            PG8_LDB(B1, 0, 1); PG8_STAGE(PG8_SB(0, 0), b2, voffB);
            PG8_BAR; PG8_WAIT_L(0); PG8_MMA(0, 1, At, B1); PG8_BAR;
            PG8_LDA(At, 0, 1); PG8_STAGE(PG8_SA(0, 0), a2, voffA);
            PG8_BAR; PG8_WAIT_L(0); PG8_MMA(1, 0, At, B0); PG8_BAR; PG8_SCHED;
            PG8_STAGE(PG8_SB(0, 1), b2 + hstep, voffB);
            PG8_WAIT_V(6); PG8_BAR; PG8_MMA(1, 1, At, B1); PG8_BAR;
            PG8_LDB(B0, 1, 0); PG8_SCHED; PG8_LDA(At, 1, 0); PG8_STAGE(PG8_SA(0, 1), a2 + hstep, voffA);
            PG8_WAIT_L(8); PG8_BAR; PG8_WAIT_L(0); PG8_MMA(0, 0, At, B0); PG8_BAR; PG8_SCHED;
            PG8_LDB(B1, 1, 1); PG8_STAGE(PG8_SB(1, 0), b3, voffB);
            PG8_BAR; PG8_WAIT_L(0); PG8_MMA(0, 1, At, B1); PG8_BAR;
            PG8_LDA(At, 1, 1); PG8_STAGE(PG8_SA(1, 0), a3, voffA);
            PG8_BAR; PG8_WAIT_L(0); PG8_MMA(1, 0, At, B0); PG8_BAR; PG8_SCHED;
            PG8_STAGE(PG8_SB(1, 1), b3 + hstep, voffB);
            PG8_WAIT_V(6); PG8_BAR; PG8_MMA(1, 1, At, B1); PG8_BAR;
            }
        }
        if constexpr (ALIGN_EPI) { if (wr == 0) PG8_BAR; }
        if constexpr (!Epi::AFTER_DRAIN) { E(acc, cur, wr, wc, fr, fq); S.done(cur); }
        if (!has_next) break;
#pragma unroll
        for (int a = 0; a < 2; ++a)
#pragma unroll
            for (int b = 0; b < 2; ++b)
#pragma unroll
                for (int m = 0; m < 4; ++m)
#pragma unroll
                    for (int n = 0; n < 2; ++n) acc[a][b][m][n] = (f32x4){0.f, 0.f, 0.f, 0.f};
        cur = nxt; cA = nA; cB = nB; ++ui;
        if constexpr (ALIGN_EPI) { if (wr == 1) PG8_BAR; }
    }
    PG8_WAIT_V(0);
    if constexpr (!ALIGN_EPI) { if (wr == 0) PG8_BAR; }
    PG8_BAR;
    if constexpr (Epi::AFTER_DRAIN) { E.fused(acc, cur, wr, wc, fr, fq, lds, wid, lane); S.done(cur); }
#undef PG8_SA
#undef PG8_SB
#undef PG8_STAGE
#undef PG8_LDA
#undef PG8_LDB
#undef PG8_MMA
#undef PG8_WAIT_V
#undef PG8_WAIT_L
#undef PG8_BAR
#undef PG8_SCHED
}
constexpr int OUT_KP = 34078720, OUT_VP = 34111488, OUT_PP = 34144256, OUT_KS = 34159616, OUT_VS = 34225152, OUT_PS = 34290688;
constexpr float QSCALE = 0.125f * 1.4426950408889634f;
constexpr float RMS_EPS = 1e-6f;

__device__ __forceinline__ u32x4 pack8(f32x4 v0, f32x4 v1) { u32x4 w; w.x = cvt_pk_bf16(v0[0], v0[1]); w.y = cvt_pk_bf16(v0[2], v0[3]); w.z = cvt_pk_bf16(v1[0], v1[1]); w.w = cvt_pk_bf16(v1[2], v1[3]); return w; }
__device__ __forceinline__ float bf_lo(unsigned w) { return __uint_as_float(w << 16); }
__device__ __forceinline__ float bf_hi(unsigned w) { return __uint_as_float(w & 0xffff0000u); }

typedef unsigned u32x2 __attribute__((ext_vector_type(2)));
__device__ __forceinline__ u32x2 pack4(f32x4 v) { u32x2 w; w.x = cvt_pk_bf16(v[0], v[1]); w.y = cvt_pk_bf16(v[2], v[3]); return w; }
struct EpiPlain {
    static constexpr bool PERM = true, AFTER_DRAIN = false, HAS_SSQ = false;
    bf16_t* O; int ldc;
    __device__ __forceinline__ float* ssq_dst() const { return nullptr; }
    __device__ __forceinline__ float quad(int row, int col, f32x4 v) const { *(u32x2*)(O + (size_t)row * ldc + col) = pack4(v); return 0.f; }
    __device__ __forceinline__ void operator()(const f32x4 (&acc)[2][2][4][2], const Unit& u, int wr, int wc, int fr, int fq) const {
        const int row0 = u.pm * BM + wr * 64 + fr, col0 = u.pn * BM + wc * 32 + 8 * fq;
#pragma unroll
        for (int ai = 0; ai < 2; ++ai)
#pragma unroll
            for (int m = 0; m < 4; ++m) { bf16_t* rowp = O + (size_t)(row0 + ai * HALF + m * 16) * ldc + col0;
#pragma unroll
                for (int bj = 0; bj < 2; ++bj) *(u32x4*)(rowp + bj * HALF) = pack8(acc[ai][bj][m][0], acc[ai][bj][m][1]); }
    }
};
struct EpiIn {
    static constexpr bool PERM = true, AFTER_DRAIN = false, HAS_SSQ = false;
    bf16_t* Z; float* out;
    __device__ __forceinline__ float* ssq_dst() const { return nullptr; }
    __device__ __forceinline__ float quad(int row, int col, f32x4 v) const {
        const float sc = (col < 512) ? QSCALE : 1.f;
        *(u32x2*)(Z + (size_t)row * 1280 + col) = pack4(v * sc);
        if (col >= 512) { const int rs = row - 32768, b = rs >> 4, t = rs & 15; long dst = -1;
            if (col < 640) dst = OUT_KS + (long)rs * 128 + (col - 512);
            else if (col < 768) dst = OUT_VS + (long)rs * 128 + (col - 640);
            else if (t >= 1) dst = OUT_PS + (long)(b * 15 + (t - 1)) * 512 + (col - 768);
            if (dst >= 0) *(f32x4*)(out + dst) = v; }
        return 0.f; }
    __device__ __forceinline__ void operator()(const f32x4 (&acc)[2][2][4][2], const Unit& u, int wr, int wc, int fr, int fq) const {
        const int row0 = u.pm * BM + wr * 64 + fr, col0 = u.pn * BM + wc * 32 + 8 * fq;
        const float sc = (u.pn < 2) ? QSCALE : 1.f;
#pragma unroll
        for (int ai = 0; ai < 2; ++ai)
#pragma unroll
            for (int m = 0; m < 4; ++m) { bf16_t* rowp = Z + (size_t)(row0 + ai * HALF + m * 16) * 1280 + col0;
#pragma unroll
                for (int bj = 0; bj < 2; ++bj) *(u32x4*)(rowp + bj * HALF) = pack8(acc[ai][bj][m][0] * sc, acc[ai][bj][m][1] * sc); }
        const bool special = (u.pn >= 2) && (u.pm == 63 || u.pm == 127);
        if (special) {
#pragma unroll
            for (int ai = 0; ai < 2; ++ai)
#pragma unroll
                for (int m = 0; m < 4; ++m) { const int row = row0 + ai * HALF + m * 16;
#pragma unroll
                    for (int bj = 0; bj < 2; ++bj) { const int col = col0 + bj * HALF;
                        long dst = -1;
                        if (row < 32768) { const int b = row >> 14, t = row & 16383;
                            if (col < 640) { if (t >= 16256) dst = OUT_KP + (long)(b * 128 + (t - 16256)) * 128 + (col - 512); }
                            else if (col < 768) { if (t >= 16256) dst = OUT_VP + (long)(b * 128 + (t - 16256)) * 128 + (col - 640); }
                            else { if (t >= 16369) dst = OUT_PP + (long)(b * 15 + (t - 16369)) * 512 + (col - 768); }
                        } else { const int rs = row - 32768, b = rs >> 4, t = rs & 15;
                            if (col < 640) dst = OUT_KS + (long)rs * 128 + (col - 512);
                            else if (col < 768) dst = OUT_VS + (long)rs * 128 + (col - 640);
                            else { if (t >= 1) dst = OUT_PS + (long)(b * 15 + (t - 1)) * 512 + (col - 768); }
                        }
                        if (dst >= 0) { *(f32x4*)(out + dst) = acc[ai][bj][m][0]; *(f32x4*)(out + dst + 4) = acc[ai][bj][m][1]; } } }
        }
    }
};
__device__ __forceinline__ float sq8(f32x4 v0, f32x4 v1) { return (v0[0] * v0[0] + v0[1] * v0[1]) + (v0[2] * v0[2] + v0[3] * v0[3]) + (v1[0] * v1[0] + v1[1] * v1[1]) + (v1[2] * v1[2] + v1[3] * v1[3]); }
__device__ __forceinline__ void unpack8(u32x4 w, f32x4& v0, f32x4& v1) { v0 = (f32x4){bf_lo(w.x), bf_hi(w.x), bf_lo(w.y), bf_hi(w.y)}; v1 = (f32x4){bf_lo(w.z), bf_hi(w.z), bf_lo(w.w), bf_hi(w.w)}; }
struct EpiRes1 {
    static constexpr bool PERM = true, AFTER_DRAIN = false, HAS_SSQ = true;
    const float* xp; const float* xs; bf16_t* xb; float* ssq;
    __device__ __forceinline__ float* ssq_dst() const { return ssq; }
    __device__ __forceinline__ float quad(int row, int col, f32x4 acc) const {
        const size_t off = (size_t)row * 1024 + col;
        const float* src = (row < 32768 ? xp + off : xs + (off - (size_t)32768 * 1024));
        const f32x4 v = *(const f32x4*)src + acc;
        *(u32x2*)(xb + off) = pack4(v);
        return (v[0] * v[0] + v[1] * v[1]) + (v[2] * v[2] + v[3] * v[3]); }
    __device__ __forceinline__ void operator()(const f32x4 (&acc)[2][2][4][2], const Unit& u, int wr, int wc, int fr, int fq) const {
        const int row0 = u.pm * BM + wr * 64 + fr, col0 = u.pn * BM + wc * 32 + 8 * fq;
#pragma unroll
        for (int ai = 0; ai < 2; ++ai) {
            f32x4 r[4][2][2];
#pragma unroll
            for (int m = 0; m < 4; ++m) { const float* src = xp + (size_t)(row0 + ai * HALF + m * 16) * 1024 + col0;
#pragma unroll
                for (int bj = 0; bj < 2; ++bj) { r[m][bj][0] = *(const f32x4*)(src + bj * HALF); r[m][bj][1] = *(const f32x4*)(src + bj * HALF + 4); } }
            float s4[4];
#pragma unroll
            for (int m = 0; m < 4; ++m) { const size_t off = (size_t)(row0 + ai * HALF + m * 16) * 1024 + col0; float s = 0.f;
#pragma unroll
                for (int bj = 0; bj < 2; ++bj) { const f32x4 v0 = r[m][bj][0] + acc[ai][bj][m][0], v1 = r[m][bj][1] + acc[ai][bj][m][1];
                    *(u32x4*)(xb + off + bj * HALF) = pack8(v0, v1); s += sq8(v0, v1); }
                s += __shfl_xor(s, 16); s += __shfl_xor(s, 32); s4[m] = s; }
            if (fq == 0) {
#pragma unroll
                for (int m = 0; m < 4; ++m) atomicAdd(ssq + row0 + ai * HALF + m * 16, s4[m]); }
        }
    }
};
struct EpiRes2 {
    static constexpr bool PERM = true, AFTER_DRAIN = false, HAS_SSQ = true;
    const bf16_t* xin; bf16_t* xb; float* ssq;
    __device__ __forceinline__ float* ssq_dst() const { return ssq; }
    __device__ __forceinline__ float quad(int row, int col, f32x4 acc) const {
        const size_t off = (size_t)row * 1024 + col; const u32x2 w = *(const u32x2*)(xin + off);
        const f32x4 v = (f32x4){bf_lo(w.x), bf_hi(w.x), bf_lo(w.y), bf_hi(w.y)} + acc;
        *(u32x2*)(xb + off) = pack4(v);
        return (v[0] * v[0] + v[1] * v[1]) + (v[2] * v[2] + v[3] * v[3]); }
    __device__ __forceinline__ void operator()(const f32x4 (&acc)[2][2][4][2], const Unit& u, int wr, int wc, int fr, int fq) const {
        const int row0 = u.pm * BM + wr * 64 + fr, col0 = u.pn * BM + wc * 32 + 8 * fq;
        u32x4 r[2][4][2];
#pragma unroll
        for (int ai = 0; ai < 2; ++ai)
#pragma unroll
            for (int m = 0; m < 4; ++m)
#pragma unroll
                for (int bj = 0; bj < 2; ++bj) r[ai][m][bj] = *(const u32x4*)(xin + (size_t)(row0 + ai * HALF + m * 16) * 1024 + col0 + bj * HALF);
        float s8[8];
#pragma unroll
        for (int ai = 0; ai < 2; ++ai)
#pragma unroll
            for (int m = 0; m < 4; ++m) { const size_t off = (size_t)(row0 + ai * HALF + m * 16) * 1024 + col0; float s = 0.f;
#pragma unroll
                for (int bj = 0; bj < 2; ++bj) { f32x4 v0, v1; unpack8(r[ai][m][bj], v0, v1); v0 += acc[ai][bj][m][0]; v1 += acc[ai][bj][m][1];
                    *(u32x4*)(xb + off + bj * HALF) = pack8(v0, v1); s += sq8(v0, v1); }
                s += __shfl_xor(s, 16); s += __shfl_xor(s, 32); s8[ai * 4 + m] = s; }
        if (fq == 0) {
#pragma unroll
            for (int i = 0; i < 8; ++i) atomicAdd(ssq + row0 + (i >> 2) * HALF + (i & 3) * 16, s8[i]); }
    }
};
struct EpiUp {
    static constexpr bool PERM = true, AFTER_DRAIN = false, HAS_SSQ = false;
    bf16_t* H; const float* ssq;
    __device__ __forceinline__ float* ssq_dst() const { return nullptr; }
    __device__ __forceinline__ float quad(int row, int col, f32x4 acc) const {
        const float rs = rsqrtf(ssq[row] * (1.f / 1024.f) + RMS_EPS); f32x4 v = acc * rs;
#pragma unroll
        for (int e = 0; e < 4; ++e) { const float a = fmaxf(v[e], 0.f); v[e] = a * a; }
        *(u32x2*)(H + (size_t)row * 4096 + col) = pack4(v); return 0.f; }
    __device__ __forceinline__ void operator()(const f32x4 (&acc)[2][2][4][2], const Unit& u, int wr, int wc, int fr, int fq) const {
        const int row0 = u.pm * BM + wr * 64 + fr, col0 = u.pn * BM + wc * 32 + 8 * fq;
#pragma unroll
        for (int ai = 0; ai < 2; ++ai)
#pragma unroll
            for (int m = 0; m < 4; ++m) { const int row = row0 + ai * HALF + m * 16; const float rs = rsqrtf(ssq[row] * (1.f / 1024.f) + RMS_EPS);
                bf16_t* rowp = H + (size_t)row * 4096 + col0;
#pragma unroll
                for (int bj = 0; bj < 2; ++bj) { f32x4 v0 = acc[ai][bj][m][0] * rs, v1 = acc[ai][bj][m][1] * rs;
#pragma unroll
                    for (int e = 0; e < 4; ++e) { const float a = fmaxf(v0[e], 0.f), b = fmaxf(v1[e], 0.f); v0[e] = a * a; v1[e] = b * b; }
                    *(u32x4*)(rowp + bj * HALF) = pack8(v0, v1); } }
    }
};
struct EpiGate {
    static constexpr bool PERM = true, AFTER_DRAIN = false, HAS_SSQ = true;
    const bf16_t* xb; bf16_t* x3b; const bf16_t* pp; const float* ssq_in; float* ssq_out;
    __device__ __forceinline__ float* ssq_dst() const { return ssq_out; }
    __device__ __forceinline__ float quad(int row, int col, f32x4 acc) const {
        const size_t off = (size_t)row * 1024 + col;
        const float rs = rsqrtf(ssq_in[row] * (1.f / 1024.f) + RMS_EPS) * (-1.4426950408889634f);
        const u32x2 xw = *(const u32x2*)(xb + off); const u32x2 pw = *(const u32x2*)(pp + off);
        const f32x4 a0 = (f32x4){bf_lo(xw.x), bf_hi(xw.x), bf_lo(xw.y), bf_hi(xw.y)}, p0 = (f32x4){bf_lo(pw.x), bf_hi(pw.x), bf_lo(pw.y), bf_hi(pw.y)}; f32x4 v;
#pragma unroll
        for (int e = 0; e < 4; ++e) v[e] = a0[e] + __builtin_amdgcn_rcpf(1.f + __builtin_amdgcn_exp2f(acc[e] * rs)) * p0[e];
        *(u32x2*)(x3b + off) = pack4(v);
        return (v[0] * v[0] + v[1] * v[1]) + (v[2] * v[2] + v[3] * v[3]); }
    __device__ __forceinline__ void operator()(const f32x4 (&acc)[2][2][4][2], const Unit& u, int wr, int wc, int fr, int fq) const {
        const int row0 = u.pm * BM + wr * 64 + fr, col0 = u.pn * BM + wc * 32 + 8 * fq;
#pragma unroll
        for (int ai = 0; ai < 2; ++ai) {
            u32x4 rx[4][2], rp[4][2]; float rs4[4];
#pragma unroll
            for (int m = 0; m < 4; ++m) { const int row = row0 + ai * HALF + m * 16; const size_t off = (size_t)row * 1024 + col0;
                rs4[m] = ssq_in[row];
#pragma unroll
                for (int bj = 0; bj < 2; ++bj) { rx[m][bj] = *(const u32x4*)(xb + off + bj * HALF); rp[m][bj] = *(const u32x4*)(pp + off + bj * HALF); } }
            float s4[4];
#pragma unroll
            for (int m = 0; m < 4; ++m) { const size_t off = (size_t)(row0 + ai * HALF + m * 16) * 1024 + col0; float s = 0.f;
                const float rs = rsqrtf(rs4[m] * (1.f / 1024.f) + RMS_EPS) * (-1.4426950408889634f);
#pragma unroll
                for (int bj = 0; bj < 2; ++bj) { f32x4 a0, a1, p0, p1; unpack8(rx[m][bj], a0, a1); unpack8(rp[m][bj], p0, p1); f32x4 v0, v1;
#pragma unroll
                    for (int e = 0; e < 4; ++e) { const float g0 = __builtin_amdgcn_rcpf(1.f + __builtin_amdgcn_exp2f(acc[ai][bj][m][0][e] * rs)), g1 = __builtin_amdgcn_rcpf(1.f + __builtin_amdgcn_exp2f(acc[ai][bj][m][1][e] * rs));
                        v0[e] = a0[e] + g0 * p0[e]; v1[e] = a1[e] + g1 * p1[e]; }
                    *(u32x4*)(x3b + off + bj * HALF) = pack8(v0, v1); s += sq8(v0, v1); }
                s += __shfl_xor(s, 16); s += __shfl_xor(s, 32); s4[m] = s; }
            if (fq == 0) {
#pragma unroll
                for (int m = 0; m < 4; ++m) atomicAdd(ssq_out + row0 + ai * HALF + m * 16, s4[m]); }
        }
    }
};
}
constexpr int NWAVES = 8;
constexpr int MP = 32768, MS = 512, M = MP + MS;
constexpr int D = 1024, NIN = 1280, FF = 4096, PLE = 256, SEQ = 16384;
#ifndef MK_N_LAUNCHES
#define MK_N_LAUNCHES 1
#endif
constexpr int N_PHASES = 8;
constexpr size_t MiB = 1u << 20;
constexpr size_t WS_CTL = 0, CTL_ZERO_BYTES = 1 * MiB;
constexpr size_t WS_SSQ1 = 0, WS_SSQ2 = 160 * 1024, WS_SSQ3 = 320 * 1024, WS_BAR = 512 * 1024;
constexpr size_t WS_WIN = 1 * MiB;
constexpr size_t WS_WO = 4 * MiB;
constexpr size_t WS_WUP = 6 * MiB;
constexpr size_t WS_WD = 14 * MiB;
constexpr size_t WS_WG = 22 * MiB;
constexpr size_t WS_WPLE = 24 * MiB;
constexpr size_t WS_WPOOL = 24 * MiB + 512 * 1024;
constexpr size_t WS_PLEB = 26 * MiB;
constexpr size_t WS_PP = 43 * MiB;
constexpr size_t WS_XB = 108 * MiB;
constexpr size_t WS_H = 173 * MiB;
constexpr size_t WS_Z = 173 * MiB;
constexpr size_t WS_MIX = 255 * MiB;
constexpr size_t WS_XB2 = 433 * MiB;
constexpr size_t WS_END = 498 * MiB;
static_assert(WS_Z + (size_t)M * NIN * 2 <= WS_MIX && WS_MIX + (size_t)M * D * 2 <= WS_END && WS_H + (size_t)M * FF * 2 <= WS_END && WS_XB + (size_t)M * D * 2 <= WS_H && WS_PP + (size_t)M * D * 2 <= WS_XB && WS_PLEB + (size_t)M * PLE * 2 <= WS_PP, "d_ws map");
constexpr int LDS_BYTES = 155648;
constexpr int MISC_OFF = 151 * 1024;
#define GAS __attribute__((address_space(1)))
#define LAS __attribute__((address_space(3)))
typedef unsigned short bf16;
typedef unsigned v4u __attribute__((ext_vector_type(4)));
typedef unsigned v2u __attribute__((ext_vector_type(2)));
typedef float f32x4 __attribute__((ext_vector_type(4)));
typedef float f32x16 __attribute__((ext_vector_type(16)));
typedef short bf16x8 __attribute__((ext_vector_type(8)));
typedef short s16x4 __attribute__((ext_vector_type(4)));
#define LDS_WAIT() asm volatile("s_waitcnt lgkmcnt(0)" ::: "memory")
__device__ __forceinline__ unsigned f2bf(float f) { unsigned u = __builtin_bit_cast(unsigned, f); return (u + 0x7fffu + ((u >> 16) & 1u)) >> 16; }
__device__ __forceinline__ unsigned pk2(float lo, float hi) { return f2bf(lo) | (f2bf(hi) << 16); }
__device__ __forceinline__ float bflo(unsigned w) { return __uint_as_float(w << 16); }
__device__ __forceinline__ float bfhi(unsigned w) { return __uint_as_float(w & 0xffff0000u); }
__device__ __forceinline__ float wave_sum(float v) {
#pragma unroll
    for (int o = 1; o < 64; o <<= 1) v += __shfl_xor(v, o);
    return v;
}

#define RLX_AGENT __ATOMIC_RELAXED, __HIP_MEMORY_SCOPE_AGENT
#define XB_TMO      128
#define XB_XCNT(j)  (256  + 64 * (j))
#define XB_XSUB(j)  (1280 + 64 * (j))
#define XB_XGEN(j)  (2304 + 64 * (j))
#define XB_TOP      3328
#define XB_TOPGEN   3392
#define XCD_BAR_WORDS 3456
#define XB_SPIN_CAP (1u << 18)

__device__ __forceinline__ unsigned xb_ld(unsigned* p)              { return __hip_atomic_load(p, __ATOMIC_RELAXED, __HIP_MEMORY_SCOPE_AGENT); }
__device__ __forceinline__ unsigned xb_add(unsigned* p, unsigned v) { return __hip_atomic_fetch_add(p, v, __ATOMIC_RELAXED, __HIP_MEMORY_SCOPE_AGENT); }
__device__ __forceinline__ unsigned xb_xcc_id() { return (unsigned)__builtin_amdgcn_s_getreg((3 << 11) | 20) & 0xFu; }
#define XB_SPIN(cond, bar) do { unsigned _sp = 0; while (cond) { __builtin_amdgcn_s_sleep(1); \
    if ((++_sp & 255u) == 0u) { if (xb_ld(&(bar)[XB_TMO])) break; if (_sp > XB_SPIN_CAP) { atomicAdd(&(bar)[XB_TMO], 1u); break; } } } } while (0)

struct XcdBarrier {
    unsigned* bar; unsigned x;
    volatile LAS unsigned* st;
};

__device__ __forceinline__ XcdBarrier xcd_barrier_post(unsigned* bar, volatile LAS unsigned* st, bool leader) {
    XcdBarrier b; b.bar = bar; b.x = xb_xcc_id(); b.st = st;
    if (leader) (void)xb_add(&bar[XB_XCNT(b.x)], 1u);
    return b;
}
__device__ __forceinline__ void xcd_barrier_complete(unsigned* bar, unsigned x, unsigned& nloc, unsigned& nx) {
    const unsigned G = gridDim.x * gridDim.y * gridDim.z;
    unsigned sum, cnt, mine, sp = 0u;
    for (;;) {
        sum = 0u; cnt = 0u; mine = 0u;
#pragma unroll
        for (unsigned j = 0; j < 16; ++j) { const unsigned c = xb_ld(&bar[XB_XCNT(j)]); sum += c; cnt += (c > 0u) ? 1u : 0u; mine = (j == x) ? c : mine; }
        if (sum == G) break;
        __builtin_amdgcn_s_sleep(1);
        if ((++sp & 255u) == 0u) { if (xb_ld(&bar[XB_TMO])) break; if (sp > XB_SPIN_CAP) { atomicAdd(&bar[XB_TMO], 1u); break; } }
    }
    nloc = mine > 0u ? mine : 1u; nx = cnt > 0u ? cnt : 1u;
}

__device__ __forceinline__ void xcd_barrier(const XcdBarrier& b, bool leader) {
    asm volatile("s_waitcnt vmcnt(0)" ::: "memory");
    __syncthreads();
    if (leader) {
        unsigned* bar = b.bar;
        __builtin_amdgcn_s_waitcnt(0);
        unsigned nloc = b.st[0], nx = b.st[1];
        if (nloc == 0u) { xcd_barrier_complete(bar, b.x, nloc, nx); b.st[0] = nloc; b.st[1] = nx; }
        const unsigned old = xb_add(&bar[XB_XSUB(b.x)], 1u);
        const unsigned gen = old / nloc;
        if (old + 1u == (gen + 1u) * nloc) {
            __builtin_amdgcn_fence(__ATOMIC_RELEASE, "agent");
            asm volatile("s_waitcnt vmcnt(0)" ::: "memory");
            const unsigned og = xb_add(&bar[XB_TOP], 1u);
            const unsigned tg = og / nx;
            if (og + 1u == (tg + 1u) * nx) xb_add(&bar[XB_TOPGEN], 1u);
            else XB_SPIN(xb_ld(&bar[XB_TOPGEN]) == tg, bar);
            __builtin_amdgcn_fence(__ATOMIC_ACQUIRE, "agent");
            xb_add(&bar[XB_XGEN(b.x)], 1u);
            asm volatile("s_waitcnt vmcnt(0)" ::: "memory");
        } else {
            XB_SPIN(xb_ld(&bar[XB_XGEN(b.x)]) == gen, bar);
            __builtin_amdgcn_fence(__ATOMIC_ACQUIRE, "agent");
            asm volatile("s_waitcnt vmcnt(0)" ::: "memory");
        }
    }
    __syncthreads();
}

struct Params { const float* in[22]; float* out; unsigned char* ws; int ph_lo, ph_hi; };
struct Frame { LAS unsigned char* lds; int tid, lane, wave, vcu, G; };
#define FRAME_LANES(F) do { (F).lane = pg8::lane_id(); (F).tid = (F).wave * 64 + (F).lane; } while (0)
typedef const __attribute__((address_space(4))) Params* KPtr;
__device__ __forceinline__ KPtr kparams() { KPtr k = (KPtr)__builtin_amdgcn_kernarg_segment_ptr(); asm volatile("" : "+s"(k)); return k; }

__device__ __forceinline__ void p0_transpose_item(const float* W, const float* g, int K, int N, bf16* WT, LAS float* scr, int item, int lane) {
    const int nblk = N / 32, kb = item / nblk, nb = item % nblk, k0 = 64 * kb, n0 = 32 * nb;
#pragma unroll 8
    for (int i = 0; i < 32; ++i) { const int kk = 2 * i + (lane >> 5); const float gv = g ? g[k0 + kk] : 1.f; scr[kk * 33 + (lane & 31)] = W[(size_t)(k0 + kk) * N + n0 + (lane & 31)] * gv; }
    LDS_WAIT(); asm volatile("" ::: "memory");
    const int c = lane & 7;
#pragma unroll
    for (int j = 0; j < 4; ++j) { const int n = (lane >> 3) + 8 * j; const LAS float* s = scr + (8 * c) * 33 + n;
        v4u o; o.x = pk2(s[0 * 33], s[1 * 33]); o.y = pk2(s[2 * 33], s[3 * 33]); o.z = pk2(s[4 * 33], s[5 * 33]); o.w = pk2(s[6 * 33], s[7 * 33]);
        *(GAS v4u*)(WT + (size_t)(n0 + n) * K + k0 + 8 * c) = o; }
    LDS_WAIT(); asm volatile("" ::: "memory");
}
__device__ __forceinline__ void p0_prologue(const Frame& F, KPtr P) {
    LAS float* scr = (LAS float*)(F.lds + F.wave * 16384);
    const int gw = F.vcu * NWAVES + F.wave, NGW = F.G * NWAVES;
    unsigned char* ws = P->ws;
    constexpr int I_IN = 16 * 40, I_O = 16 * 32, I_UP = 16 * 128, I_D = 64 * 32, I_G = 16 * 32, I_PLE = 4 * 32, I_POOL = 4 * 8;
    constexpr int NITEMS = I_IN + I_O + I_UP + I_D + I_G + I_PLE + I_POOL;
    for (int it = gw; it < NITEMS; it += NGW) {
        int r = it;
        if (r < I_UP) { p0_transpose_item(P->in[16], P->in[15], D, FF, (bf16*)(ws + WS_WUP), scr, r, F.lane); continue; } r -= I_UP;
        if (r < I_D) { p0_transpose_item(P->in[17], nullptr, FF, D, (bf16*)(ws + WS_WD), scr, r, F.lane); continue; } r -= I_D;
        if (r < I_IN) { p0_transpose_item(P->in[8], nullptr, D, NIN, (bf16*)(ws + WS_WIN), scr, r, F.lane); continue; } r -= I_IN;
        if (r < I_O) { p0_transpose_item(P->in[14], nullptr, D, D, (bf16*)(ws + WS_WO), scr, r, F.lane); continue; } r -= I_O;
        if (r < I_G) { p0_transpose_item(P->in[19], P->in[18], D, D, (bf16*)(ws + WS_WG), scr, r, F.lane); continue; } r -= I_G;
        if (r < I_PLE) { p0_transpose_item(P->in[20], nullptr, PLE, D, (bf16*)(ws + WS_WPLE), scr, r, F.lane); continue; } r -= I_PLE;
        { const int g = r >> 3; p0_transpose_item(P->in[11] + g * 16384, nullptr, 128, 128, (bf16*)(ws + WS_WPOOL) + g * 16384, scr, r & 7, F.lane); }
    }
    const float* lnm = P->in[7];
    f32x4 gv[4];
#pragma unroll
    for (int j = 0; j < 4; ++j) gv[j] = ((const f32x4*)lnm)[F.lane + 64 * j];
    bf16* XN = (bf16*)(ws + WS_XB);
    for (int m = gw; m < M; m += NGW) {
        const float* xrow = (m < MP) ? P->in[0] + (size_t)m * D : P->in[1] + (size_t)(m - MP) * D;
        const GAS f32x4* xr = (const GAS f32x4*)xrow + F.lane;
        f32x4 v[4]; float s = 0.f;
#pragma unroll
        for (int j = 0; j < 4; ++j) { v[j] = xr[64 * j]; s += (v[j].x * v[j].x + v[j].y * v[j].y) + (v[j].z * v[j].z + v[j].w * v[j].w); }
        const float rstd = rsqrtf(wave_sum(s) * (1.f / D) + pg8::RMS_EPS);
        GAS v2u* o8 = (GAS v2u*)(XN + (size_t)m * D) + F.lane;
#pragma unroll
        for (int j = 0; j < 4; ++j) { v2u o; o.x = pk2(v[j].x * rstd * gv[j].x, v[j].y * rstd * gv[j].y); o.y = pk2(v[j].z * rstd * gv[j].z, v[j].w * rstd * gv[j].w); o8[64 * j] = o; }
    }
    bf16* PB = (bf16*)(ws + WS_PLEB);
    for (int m = gw; m < M; m += NGW) {
        const float* prow = (m < MP) ? P->in[5] + (size_t)m * PLE : P->in[6] + (size_t)(m - MP) * PLE;
        const f32x4 v = ((const GAS f32x4*)prow)[F.lane];
        v2u o; o.x = pk2(v.x, v.y); o.y = pk2(v.z, v.w);
        ((GAS v2u*)(PB + (size_t)m * PLE))[F.lane] = o;
    }
}

constexpr int KSB = 272;
constexpr int L_K = 0, L_V = 192 * KSB, L_U = 0, USB = 1040  , L_SCR = 120 * 1024, L_D = 82176  , L_SCR2 = 148736;
static_assert(2 * 192 * KSB <= L_SCR && 79 * USB <= L_D && L_D + 64 * USB <= L_SCR2 && L_SCR2 + 2048 <= MISC_OFF && MISC_OFF + 64 <= LDS_BYTES, "P2 LDS map");
__device__ __forceinline__ int crow(int r, int hi) { return (r & 3) + 8 * (r >> 2) + 4 * hi; }
__device__ __forceinline__ bf16x8 pack_step(const f32x16& x, int s) {
    v4u p; p.x = pg8::cvt_pk_bf16(x[8 * s], x[8 * s + 1]); p.y = pg8::cvt_pk_bf16(x[8 * s + 2], x[8 * s + 3]); p.z = pg8::cvt_pk_bf16(x[8 * s + 4], x[8 * s + 5]); p.w = pg8::cvt_pk_bf16(x[8 * s + 6], x[8 * s + 7]);
    return __builtin_bit_cast(bf16x8, p);
}
typedef short v4i16_t __attribute__((ext_vector_type(4)));
__device__ __forceinline__ s16x4 vtr(const LAS unsigned char* p) { return __builtin_bit_cast(s16x4, __builtin_amdgcn_ds_read_tr16_b64_v4i16((LAS v4i16_t*)p)); }

__device__ __forceinline__ void mix_unit(const Frame& F, KPtr P, int unit) {
    unsigned char* ws = P->ws;
    const bf16* Z = (const bf16*)(ws + WS_Z);
    bf16* MIX = (bf16*)(ws + WS_MIX);
    const int tid = F.tid, lane = F.lane, wave = F.wave, r32 = lane & 31, hi = lane >> 5;
    LAS unsigned char* lds = F.lds;
    const bool prompt = unit < 512;
    int qrow0, nq, kmin, kmax, pos0, sb = 0;
    if (prompt) { const int b = unit >> 8, c = unit & 255; qrow0 = b * SEQ + c * 64; nq = 64; kmin = (c >= 2) ? 0 : (2 - c) * 64; kmax = 192; pos0 = c * 64; }
    else { sb = unit - 512; qrow0 = MP + sb * 16; nq = 16; kmin = 0; kmax = 144; pos0 = 2048; }
    const int nqt = (nq + 31) >> 5;
    const int hd = wave, kvh = wave >> 2;
    bf16x8 qr[2][4];
#pragma unroll
    for (int qt = 0; qt < 2; ++qt) { const int ql = 32 * qt + r32; const int qrow = qrow0 + (ql < nq ? ql : 0);
#pragma unroll
        for (int ds = 0; ds < 4; ++ds) qr[qt][ds] = *(const GAS bf16x8*)(Z + (size_t)qrow * NIN + hd * 64 + ds * 16 + hi * 8); }
    if (prompt) {
        const int cp = tid & 31, r0 = tid >> 5;
        LAS unsigned char* dstb = lds + ((cp < 16) ? L_K : L_V) + (cp & 15) * 16 + r0 * KSB;
        const bf16* src = Z + ((long)(qrow0 - 128 + r0) * NIN + 512 + cp * 8);
        v4u val[12];
#pragma unroll
        for (int i = 0; i < 12; ++i) { val[i] = (v4u){0u, 0u, 0u, 0u}; if (16 * i >= kmin) val[i] = *(const GAS v4u*)(src + (long)(16 * i) * NIN); }
#pragma unroll
        for (int i = 0; i < 12; ++i) *(LAS v4u*)(dstb + 16 * i * KSB) = val[i];
    } else {
        const int cp = tid & 31, r0 = tid >> 5;
        LAS unsigned char* dstb = lds + ((cp < 16) ? L_K : L_V) + (cp & 15) * 16 + r0 * KSB;
        const float* csrc = ((cp < 16) ? P->in[2] : P->in[3]) + (size_t)(sb * 128 + r0) * 128 + (cp & 15) * 8;
        f32x4 ca[8][2];
#pragma unroll
        for (int i = 0; i < 8; ++i) { ca[i][0] = *(const GAS f32x4*)(csrc + (size_t)(16 * i) * 128); ca[i][1] = *(const GAS f32x4*)(csrc + (size_t)(16 * i) * 128 + 4); }
        const v4u zn = *(const GAS v4u*)(Z + (size_t)(qrow0 + r0) * NIN + 512 + cp * 8);
#pragma unroll
        for (int i = 0; i < 8; ++i) { v4u val; val.x = pk2(ca[i][0].x, ca[i][0].y); val.y = pk2(ca[i][0].z, ca[i][0].w); val.z = pk2(ca[i][1].x, ca[i][1].y); val.w = pk2(ca[i][1].z, ca[i][1].w);
            *(LAS v4u*)(dstb + 16 * i * KSB) = val; }
        *(LAS v4u*)(dstb + 128 * KSB) = zn;
#pragma unroll
        for (int i = 9; i < 12; ++i) *(LAS v4u*)(dstb + 16 * i * KSB) = (v4u){0u, 0u, 0u, 0u};
    }
    __syncthreads();
    const float sink2 = P->in[9][hd] * 1.4426950408889634f;
    LAS float* scr = (LAS float*)(lds + L_SCR);
    float biasv[6][2];
#pragma unroll
    for (int j = 0; j < 6; ++j)
#pragma unroll
        for (int rh = 0; rh < 2; ++rh) { const int k0 = 32 * j + 16 * rh; biasv[j][rh] = (k0 >= kmin && k0 < kmax) ? 0.f : -INFINITY; }
    const float* ga = P->in[10];
#ifndef NO_ATT
#pragma unroll
    for (int qt = 0; qt < 2; ++qt) if (qt < nqt) {
        f32x16 o[2];
#pragma unroll
        for (int db = 0; db < 2; ++db)
#pragma unroll
            for (int r = 0; r < 16; ++r) o[db][r] = 0.f;
        const int ql = 32 * qt + r32;
        float mx = sink2;
#pragma unroll
        for (int j = 0; j < 6; ++j) {
            f32x16 T;
#pragma unroll
            for (int r = 0; r < 16; ++r) T[r] = biasv[j][r >> 3];
#pragma unroll
            for (int ds = 0; ds < 4; ++ds) { const bf16x8 kf = *(const LAS bf16x8*)(lds + L_K + (32 * j + r32) * KSB + (kvh * 64 + ds * 16 + hi * 8) * 2);
                T = __builtin_amdgcn_mfma_f32_32x32x16_bf16(kf, qr[qt][ds], T, 0, 0, 0); }
#pragma unroll
            for (int r = 0; r < 16; ++r) mx = fmaxf(mx, T[r]);
        }
        mx = fmaxf(mx, __shfl_xor(mx, 32));
        float ls = 0.f;
        const int i16 = lane & 15, qd = i16 >> 2, pp4 = i16 & 3, blk = (lane >> 4) & 1;
        const LAS unsigned char* vbase = lds + L_V + (4 * hi + qd) * KSB + (kvh * 64 + 16 * blk + 4 * pp4) * 2;
#pragma unroll
        for (int j = 0; j < 6; ++j) {
            f32x16 T;
#pragma unroll
            for (int r = 0; r < 16; ++r) T[r] = biasv[j][r >> 3] - mx;
#pragma unroll
            for (int ds = 0; ds < 4; ++ds) { const bf16x8 kf = *(const LAS bf16x8*)(lds + L_K + (32 * j + r32) * KSB + (kvh * 64 + ds * 16 + hi * 8) * 2);
                T = __builtin_amdgcn_mfma_f32_32x32x16_bf16(kf, qr[qt][ds], T, 0, 0, 0); }
#pragma unroll
            for (int r = 0; r < 16; ++r) { T[r] = __builtin_amdgcn_exp2f(T[r]); ls += T[r]; }
#pragma unroll
            for (int s = 0; s < 2; ++s) { const bf16x8 pf = pack_step(T, s);
#pragma unroll
                for (int db = 0; db < 2; ++db) { const LAS unsigned char* vp = vbase + (32 * j + 16 * s) * KSB + 64 * db;
                    const s16x4 lo = vtr(vp), hi4 = vtr(vp + 8 * KSB);
                    const bf16x8 vf = __builtin_shufflevector(lo, hi4, 0, 1, 2, 3, 4, 5, 6, 7);
                    o[db] = __builtin_amdgcn_mfma_f32_32x32x16_bf16(vf, pf, o[db], 0, 0, 0); } }
        }
        ls += __shfl_xor(ls, 32);
        const float inv = 1.f / (ls + __builtin_amdgcn_exp2f(sink2 - mx));
        float sq = 0.f;
#pragma unroll
        for (int db = 0; db < 2; ++db)
#pragma unroll
            for (int r = 0; r < 16; ++r) { o[db][r] *= inv; sq += o[db][r] * o[db][r]; }
        sq += __shfl_xor(sq, 32);
        if (hi == 0) scr[wave * 32 + r32] = sq;
        __syncthreads();
        float tot = 0.f;
#pragma unroll
        for (int w = 0; w < 8; ++w) tot += scr[w * 32 + r32];
        const float rstd = rsqrtf(tot * (1.f / 512.f) + pg8::RMS_EPS);
        if (ql < nq) { bf16* orow = MIX + (size_t)(qrow0 + ql) * D + hd * 64;
#pragma unroll
            for (int db = 0; db < 2; ++db)
#pragma unroll
                for (int rg = 0; rg < 4; ++rg) { const int d0 = 32 * db + 8 * rg + 4 * hi; const f32x4 g = *(const f32x4*)(ga + hd * 64 + d0);
                    v2u w; w.x = pk2(o[db][4 * rg] * rstd * g.x, o[db][4 * rg + 1] * rstd * g.y); w.y = pk2(o[db][4 * rg + 2] * rstd * g.z, o[db][4 * rg + 3] * rstd * g.w);
                    *(GAS v2u*)(orow + d0) = w; } }
        __syncthreads();
    }
#endif
#ifndef NO_POOL
    bf16x8 wfr[8][2];
    { const bf16* WpTw = (const bf16*)(ws + WS_WPOOL) + (wave >> 1) * 16384 + (size_t)(64 * (wave & 1) + r32) * 128 + 8 * hi;
#pragma unroll
        for (int ks = 0; ks < 8; ++ks)
#pragma unroll
            for (int et = 0; et < 2; ++et) wfr[ks][et] = *(const GAS bf16x8*)(WpTw + (size_t)(32 * et) * 128 + 16 * ks); }
    if (prompt) {
        const int cp = tid & 63, r0 = tid >> 6;
        const bf16* src = Z + ((long)(qrow0 - 15 + r0) * NIN + 768 + cp * 8);
        LAS unsigned char* dstb = lds + L_U + r0 * USB + cp * 16;
        v4u val[10];
#pragma unroll
        for (int i = 0; i < 10; ++i) { const int row = r0 + 8 * i; val[i] = (v4u){0u, 0u, 0u, 0u}; if (row < 79 && (row >= 15 || pos0 > 0)) val[i] = *(const GAS v4u*)(src + (long)(8 * i) * NIN); }
#pragma unroll
        for (int i = 0; i < 10; ++i) if (r0 + 8 * i < 79) *(LAS v4u*)(dstb + 8 * i * USB) = val[i];
    } else {
        const int cp = tid & 63, r0 = tid >> 6;
        LAS unsigned char* dstb = lds + L_U + r0 * USB + cp * 16;
        const float* hsrc = P->in[4] + (size_t)(sb * 15 + r0) * 512 + cp * 8;
        f32x4 ha[2][2]; v4u zv[3];
#pragma unroll
        for (int i = 0; i < 2; ++i) { const bool ok = r0 + 8 * i < 15; ha[i][0] = ok ? *(const GAS f32x4*)(hsrc + (size_t)(8 * i) * 512) : (f32x4){0.f, 0.f, 0.f, 0.f}; ha[i][1] = ok ? *(const GAS f32x4*)(hsrc + (size_t)(8 * i) * 512 + 4) : (f32x4){0.f, 0.f, 0.f, 0.f}; }
#pragma unroll
        for (int i = 1; i < 4; ++i) { const int row = r0 + 8 * i; zv[i - 1] = (row >= 15 && row < 31) ? *(const GAS v4u*)(Z + (size_t)(qrow0 + row - 15) * NIN + 768 + cp * 8) : (v4u){0u, 0u, 0u, 0u}; }
#pragma unroll
        for (int i = 0; i < 6; ++i) { const int row = r0 + 8 * i; v4u val = (v4u){0u, 0u, 0u, 0u};
            if (i < 2 && row < 15) { val.x = pk2(ha[i][0].x, ha[i][0].y); val.y = pk2(ha[i][0].z, ha[i][0].w); val.z = pk2(ha[i][1].x, ha[i][1].y); val.w = pk2(ha[i][1].z, ha[i][1].w); }
            else if (i >= 1 && i < 4 && row >= 15) val = zv[i - 1];
            *(LAS v4u*)(dstb + 8 * i * USB) = val; }
    }
    __syncthreads();
    {
        const int g = wave >> 1, eh = wave & 1, w = 2 << g;
        {
            const int cpiece = g * 16 + (lane & 15), t0 = ((wave & 1) * 4 + (lane >> 4)) * 8;
            const LAS unsigned char* up = lds + L_U + (15 + t0) * USB + cpiece * 16;
            LAS unsigned char* dp = lds + L_D + t0 * USB + cpiece * 16;
            float S[8];
#pragma unroll
            for (int e = 0; e < 8; ++e) S[e] = 0.f;
            for (int i = 0; i < w; ++i) { const v4u x = *(const LAS v4u*)(up - i * USB);
                S[0] += bflo(x.x); S[1] += bfhi(x.x); S[2] += bflo(x.y); S[3] += bfhi(x.y); S[4] += bflo(x.z); S[5] += bfhi(x.z); S[6] += bflo(x.w); S[7] += bfhi(x.w); }
            v4u x0 = *(const LAS v4u*)up;
#pragma unroll
            for (int k = 0; k < 8; ++k) {
                const int pc = pos0 + t0 + k + 1; const float icnt = 1.f / (float)(pc < w ? pc : w);
                v4u dv; dv.x = pk2(S[0] * icnt - bflo(x0.x), S[1] * icnt - bfhi(x0.x)); dv.y = pk2(S[2] * icnt - bflo(x0.y), S[3] * icnt - bfhi(x0.y));
                dv.z = pk2(S[4] * icnt - bflo(x0.z), S[5] * icnt - bfhi(x0.z)); dv.w = pk2(S[6] * icnt - bflo(x0.w), S[7] * icnt - bfhi(x0.w));
                *(LAS v4u*)(dp + k * USB) = dv;
                if (k < 7) { const v4u xn = *(const LAS v4u*)(up + (k + 1) * USB), xo = *(const LAS v4u*)(up + (k + 1 - w) * USB);
                    S[0] += bflo(xn.x) - bflo(xo.x); S[1] += bfhi(xn.x) - bfhi(xo.x); S[2] += bflo(xn.y) - bflo(xo.y); S[3] += bfhi(xn.y) - bfhi(xo.y);
                    S[4] += bflo(xn.z) - bflo(xo.z); S[5] += bfhi(xn.z) - bfhi(xo.z); S[6] += bflo(xn.w) - bflo(xo.w); S[7] += bfhi(xn.w) - bfhi(xo.w); x0 = xn; }
            }
        }
        __syncthreads();
        const float* psc = P->in[12]; const float* gp = P->in[13];
        LAS float* scr2 = (LAS float*)(lds + L_SCR2);
        f32x16 bacc[2][2];
        float ssqb[2];
#pragma unroll
        for (int tt = 0; tt < 2; ++tt) {
            ssqb[tt] = 0.f;
#pragma unroll
            for (int et = 0; et < 2; ++et)
#pragma unroll
                for (int r = 0; r < 16; ++r) bacc[tt][et][r] = 0.f;
            if (tt < nqt) {
                const int t = 32 * tt + r32;
#pragma unroll
                for (int ks = 0; ks < 8; ++ks) {
                    const bf16x8 df = *(const LAS bf16x8*)(lds + L_D + t * USB + (g * 128 + 16 * ks + 8 * hi) * 2);
#pragma unroll
                    for (int et = 0; et < 2; ++et) bacc[tt][et] = __builtin_amdgcn_mfma_f32_32x32x16_bf16(wfr[ks][et], df, bacc[tt][et], 0, 0, 0);
                }
                float sq = 0.f;
#pragma unroll
                for (int et = 0; et < 2; ++et)
#pragma unroll
                    for (int rg = 0; rg < 4; ++rg) { const f32x4 sc = *(const f32x4*)(psc + g * 128 + 64 * eh + 32 * et + 8 * rg + 4 * hi);
#pragma unroll
                        for (int e = 0; e < 4; ++e) { const float v = bacc[tt][et][4 * rg + e] * sc[e]; bacc[tt][et][4 * rg + e] = v; sq += v * v; } }
                sq += __shfl_xor(sq, 32);
                ssqb[tt] = sq;
            }
        }
        if (hi == 0) { scr2[(0 * 8 + wave) * 32 + r32] = ssqb[0]; scr2[(1 * 8 + wave) * 32 + r32] = ssqb[1]; }
        __syncthreads();
#pragma unroll
        for (int tt = 0; tt < 2; ++tt) if (tt < nqt) {
            float tot = 0.f;
#pragma unroll
            for (int w2 = 0; w2 < 8; ++w2) tot += scr2[(tt * 8 + w2) * 32 + r32];
            const float rstd = rsqrtf(tot * (1.f / 512.f) + pg8::RMS_EPS);
            const int t = 32 * tt + r32;
            if (t < nq) { bf16* orow = MIX + (size_t)(qrow0 + t) * D + 512 + g * 128 + 64 * eh;
#pragma unroll
                for (int et = 0; et < 2; ++et)
#pragma unroll
                    for (int rg = 0; rg < 4; ++rg) { const int e0 = 32 * et + 8 * rg + 4 * hi; const f32x4 gg = *(const f32x4*)(gp + g * 128 + 64 * eh + e0);
                        v2u wv; wv.x = pk2(bacc[tt][et][4 * rg] * rstd * gg.x, bacc[tt][et][4 * rg + 1] * rstd * gg.y); wv.y = pk2(bacc[tt][et][4 * rg + 2] * rstd * gg.z, bacc[tt][et][4 * rg + 3] * rstd * gg.w);
                        *(GAS v2u*)(orow + e0) = wv; } }
        }
    }
    __syncthreads();
#endif
}


typedef float f32x4t __attribute__((ext_vector_type(4)));
template <class Epi>
__device__ __forceinline__ void tail_gemm(const Frame& F, const bf16* A, const bf16* Bt, int N, int K, const Epi& E) {
    const int lane = F.lane, wave = F.wave, tid = F.tid, c16 = lane & 15, g4 = lane >> 4;
    LAS float* red = (LAS float*)F.lds;
    const int ntiles = 32 * (N >> 7), kw = K >> 3;
    for (int tile = F.vcu; tile < ntiles; tile += F.G) {
        const int mt = tile & 31, nt = tile >> 5;
        f32x4t acc[8];
#pragma unroll
        for (int j = 0; j < 8; ++j) acc[j] = (f32x4t){0.f, 0.f, 0.f, 0.f};
        const bf16* ap = A + (size_t)(mt * 16 + c16) * K + wave * kw + 8 * g4;
        const bf16* bp = Bt + (size_t)(nt * 128 + c16) * K + wave * kw + 8 * g4;
#pragma unroll 4
        for (int k = 0; k < kw; k += 32) {
            const bf16x8 a = *(const GAS bf16x8*)(ap + k);
#pragma unroll
            for (int j = 0; j < 8; ++j) { const bf16x8 b = *(const GAS bf16x8*)(bp + (size_t)(16 * j) * K + k);
                acc[j] = __builtin_amdgcn_mfma_f32_16x16x32_bf16(b, a, acc[j], 0, 0, 0); }
        }
#pragma unroll
        for (int j = 0; j < 8; ++j) *(LAS f32x4t*)(red + (wave * 16 + c16) * 132 + 16 * j + 4 * g4) = acc[j];
        __syncthreads();
        const int row = tid >> 5, cg4 = (tid & 31) * 4;
        f32x4t v = (f32x4t){0.f, 0.f, 0.f, 0.f};
#pragma unroll
        for (int w = 0; w < 8; ++w) v += *(const LAS f32x4t*)(red + (w * 16 + row) * 132 + cg4);
        float sq = E.quad(MP + mt * 16 + row, nt * 128 + cg4, v);
        if (Epi::HAS_SSQ) {
#pragma unroll
            for (int o = 1; o < 32; o <<= 1) sq += __shfl_xor(sq, o);
            if ((lane & 31) == 0) atomicAdd(E.ssq_dst() + MP + mt * 16 + row, sq);
        }
        __syncthreads();
    }
}

__device__ __forceinline__ void p7_final(const Frame& F, KPtr P) {
    const int gw = F.vcu * NWAVES + F.wave, NGW = F.G * NWAVES;
    const float* ssq3 = (const float*)(P->ws + WS_SSQ3); const float* gf = P->in[21]; const bf16* X3 = (const bf16*)(P->ws + WS_Z); float* out = P->out;
    f32x4 gv[4];
#pragma unroll
    for (int j = 0; j < 4; ++j) gv[j] = ((const f32x4*)gf)[F.lane + 64 * j];
    for (int m = gw; m < M; m += NGW) {
        const GAS v2u* xr = (const GAS v2u*)(X3 + (size_t)m * D) + F.lane;
        GAS f32x4* yr = (GAS f32x4*)(out + (size_t)m * D) + F.lane;
        const float rstd = rsqrtf(ssq3[m] * (1.f / D) + pg8::RMS_EPS);
        v2u w[4];
#pragma unroll
        for (int j = 0; j < 4; ++j) w[j] = xr[64 * j];
#pragma unroll
        for (int j = 0; j < 4; ++j) { f32x4 v = (f32x4){bflo(w[j].x), bfhi(w[j].x), bflo(w[j].y), bfhi(w[j].y)}; yr[64 * j] = v * rstd * gv[j]; }
    }
}

__global__ void __launch_bounds__(NWAVES * 64, 2) trunk_fwd(Params Pv) {
    extern __shared__ __attribute__((aligned(16))) unsigned char lds[];
    Frame F;
    F.lds = (LAS unsigned char*)lds;
    { int t_ = (int)threadIdx.x; asm volatile("" : "+v"(t_)); F.wave = __builtin_amdgcn_readfirstlane(t_ >> 6); } F.tid = 0; F.lane = 0;
    F.G = gridDim.x; { const int bx = blockIdx.x; F.vcu = (F.G % 8 == 0) ? (bx % 8) * (F.G / 8) + bx / 8 : bx; }
    unsigned char* ws = kparams()->ws;
    const int lo = kparams()->ph_lo, hi = kparams()->ph_hi;
#ifndef PHASE_MASK
#define PHASE_MASK 255
#endif
#define IN(k) (((PHASE_MASK >> (k)) & 1) && lo <= (k) && (k) < hi)
    if (lo < 0) cg::this_grid().sync();
    volatile LAS unsigned* MISC = (volatile LAS unsigned*)(F.lds + MISC_OFF);
    if (pg8::lane_id() < 2 && F.wave == 0) MISC[pg8::lane_id()] = 0u;
    __syncthreads();
    XcdBarrier bar; bar.bar = (unsigned*)(ws + WS_BAR); bar.x = 0; bar.st = MISC;
    if (hi - lo > 2) bar = xcd_barrier_post((unsigned*)(ws + WS_BAR), MISC, F.wave == 0 && pg8::lane_id() == 0);
#define SEAM(k) do { if (IN(k) && IN((k) + 1)) xcd_barrier(bar, F.wave == 0 && pg8::lane_id() == 0); } while (0)
    float* ssq1 = (float*)(ws + WS_SSQ1); float* ssq2 = (float*)(ws + WS_SSQ2); float* ssq3 = (float*)(ws + WS_SSQ3);
    bf16* XB = (bf16*)(ws + WS_XB); bf16* XB2 = (bf16*)(ws + WS_XB2);

    if (IN(0)) { FRAME_LANES(F); p0_prologue(F, kparams()); }
    SEAM(0);
    if (IN(1)) {
        { pg8::Gemm g{XB, (const bf16*)(ws + WS_WIN), MP, NIN, D}; pg8::StaticOrder S; S.init(MP, NIN, F.G, (int)blockIdx.x);
          pg8::EpiIn E{(bf16*)(ws + WS_Z), kparams()->out};
          pg8::gemm_phase<pg8::EpiIn, pg8::StaticOrder, true, true>(F.lds, g, S, E, F.wave); }
        { pg8::Gemm g{(const bf16*)(ws + WS_PLEB), (const bf16*)(ws + WS_WPLE), MP, D, PLE}; pg8::StaticOrder S;
          if (F.G == 256) S.init(MP, D, 128, (int)blockIdx.x >= 128 ? (int)blockIdx.x - 128 : (1 << 24)); else S.init(MP, D, F.G, (int)blockIdx.x);
          pg8::EpiPlain E{(bf16*)(ws + WS_PP), D};
          pg8::gemm_phase<pg8::EpiPlain, pg8::StaticOrder, true, true>(F.lds, g, S, E, F.wave); }
        FRAME_LANES(F);
        { pg8::EpiIn E{(bf16*)(ws + WS_Z), kparams()->out}; tail_gemm(F, XB + (size_t)MP * D, (const bf16*)(ws + WS_WIN), NIN, D, E); }
        { pg8::EpiPlain E{(bf16*)(ws + WS_PP), D}; tail_gemm(F, (const bf16*)(ws + WS_PLEB) + (size_t)MP * PLE, (const bf16*)(ws + WS_WPLE), D, PLE, E); }
    }
    SEAM(1);
    if (IN(2)) {
        FRAME_LANES(F); for (int u = F.vcu; u < 544; u += F.G) mix_unit(F, kparams(), u);
    }
    SEAM(2);
    if (IN(3)) {
        pg8::Gemm g{(const bf16*)(ws + WS_MIX), (const bf16*)(ws + WS_WO), MP, D, D}; pg8::StaticOrder S; S.init(MP, D, F.G, (int)blockIdx.x);
        KPtr P = kparams(); pg8::EpiRes1 E{P->in[0], P->in[1], XB, ssq1};
        pg8::gemm_phase<pg8::EpiRes1, pg8::StaticOrder, true, true>(F.lds, g, S, E, F.wave);
        FRAME_LANES(F); tail_gemm(F, (const bf16*)(ws + WS_MIX) + (size_t)MP * D, (const bf16*)(ws + WS_WO), D, D, E);
    }
    SEAM(3);
    if (IN(4)) {
        pg8::Gemm g{XB, (const bf16*)(ws + WS_WUP), MP, FF, D}; pg8::StaticOrder S; S.init(MP, FF, F.G, (int)blockIdx.x);
        pg8::EpiUp E{(bf16*)(ws + WS_H), ssq1};
        pg8::gemm_phase<pg8::EpiUp, pg8::StaticOrder, true, true>(F.lds, g, S, E, F.wave);
        FRAME_LANES(F); tail_gemm(F, XB + (size_t)MP * D, (const bf16*)(ws + WS_WUP), FF, D, E);
    }
    SEAM(4);
    if (IN(5)) {
        pg8::Gemm g{(const bf16*)(ws + WS_H), (const bf16*)(ws + WS_WD), MP, D, FF}; pg8::StaticOrder S; S.init(MP, D, F.G, (int)blockIdx.x);
        pg8::EpiRes2 E{XB, XB2, ssq2};
        pg8::gemm_phase<pg8::EpiRes2, pg8::StaticOrder, true, true>(F.lds, g, S, E, F.wave);
        FRAME_LANES(F); tail_gemm(F, (const bf16*)(ws + WS_H) + (size_t)MP * FF, (const bf16*)(ws + WS_WD), D, FF, E);
    }
    SEAM(5);
    if (IN(6)) {
        pg8::Gemm g{XB2, (const bf16*)(ws + WS_WG), MP, D, D}; pg8::StaticOrder S; S.init(MP, D, F.G, (int)blockIdx.x);
        pg8::EpiGate E{XB2, (bf16*)(ws + WS_Z), (const bf16*)(ws + WS_PP), ssq2, ssq3};
        pg8::gemm_phase<pg8::EpiGate, pg8::StaticOrder, true, true>(F.lds, g, S, E, F.wave);
        FRAME_LANES(F); tail_gemm(F, XB2 + (size_t)MP * D, (const bf16*)(ws + WS_WG), D, D, E);
    }
    SEAM(6);
    if (IN(7)) { FRAME_LANES(F); p7_final(F, kparams()); }
#undef IN
#undef SEAM
}

extern "C" void kernel_launch(void* const* d_in, const int* in_sizes, int n_in, void* d_out, int out_size, void* d_ws, size_t ws_size, hipStream_t stream) {
    static int grid = 0;
    if (grid == 0) {
        if (n_in != 22 || in_sizes[0] != MP * D || out_size != 34536448 || ws_size < WS_END) { fprintf(stderr, "kernel_launch: unexpected shapes: n_in %d in0 %d out %d ws %zu (need %zu)\n", n_in, n_in > 0 ? in_sizes[0] : -1, out_size, ws_size, (size_t)WS_END); grid = -1; return; }
        int dev = 0, cus = 0, per_cu = 0;
        if (hipGetDevice(&dev) != hipSuccess || hipDeviceGetAttribute(&cus, hipDeviceAttributeMultiprocessorCount, dev) != hipSuccess) { grid = -1; return; }
        if (hipFuncSetAttribute((const void*)trunk_fwd, hipFuncAttributeMaxDynamicSharedMemorySize, LDS_BYTES) != hipSuccess) { fprintf(stderr, "kernel_launch: hipFuncSetAttribute failed\n"); grid = -1; return; }
        if (hipOccupancyMaxActiveBlocksPerMultiprocessor(&per_cu, (const void*)trunk_fwd, NWAVES * 64, LDS_BYTES) != hipSuccess || per_cu < 1) { fprintf(stderr, "kernel_launch: occupancy query says %d blocks per CU\n", per_cu); (void)hipGetLastError(); grid = -1; return; }
        grid = cus;
    }
    if (grid < 0) return;
    (void)hipMemsetAsync((char*)d_ws + WS_CTL, 0, CTL_ZERO_BYTES, stream);
    Params p{};
    for (int i = 0; i < 22; ++i) p.in[i] = (const float*)d_in[i];
    p.out = (float*)d_out; p.ws = (unsigned char*)d_ws;
#if MK_N_LAUNCHES == 1
    p.ph_lo = 0; p.ph_hi = N_PHASES;
    void* args[] = {&p};
    hipError_t e = hipLaunchCooperativeKernel((const void*)trunk_fwd, dim3(grid), dim3(NWAVES * 64), args, LDS_BYTES, stream);
    if (e != hipSuccess) fprintf(stderr, "kernel_launch: cooperative launch failed: %s (grid %d)\n", hipGetErrorString(e), grid);
#else
    for (int li = 0; li < N_PHASES; ++li) { p.ph_lo = li; p.ph_hi = li + 1; hipLaunchKernelGGL(trunk_fwd, dim3(grid), dim3(NWAVES * 64), LDS_BYTES, stream, p); }
#endif
}
```
